# Optimizing an MI355X kernel written in HIP

```python
import jax, jax.numpy as jnp
from jax import lax
import numpy as np

D_MODEL = 1024
BATCH = 4
SEQ = 4096
DEPTH = 1

GRID_W = 64
CTX_LEN = 256
N_FOURIER_GROUPS = 4
FOURIER_GROUP_W = 128
FOURIER_W = N_FOURIER_GROUPS * FOURIER_GROUP_W
N_HEADS = 8
QK_NOPE = 64
QK_ROPE = 32
HEAD_QK = QK_NOPE + QK_ROPE
V_DIM = 64
Q_LORA = 256
KV_LORA = 128
MLA_W = N_HEADS * V_DIM
N_BRANCH = 2
D_FF = 4 * D_MODEL
D_IN = FOURIER_W + Q_LORA + KV_LORA + QK_ROPE + N_BRANCH * D_MODEL
ROPE_THETA = 10000.0
Q_BLOCK = 128
EPS = 1e-6

kernel_name = "hybrid_fourier_mla_dit_block"


def rmsnorm(x, g):
    xf = x.astype(jnp.float32)
    y = xf * lax.rsqrt(jnp.mean(xf * xf, axis=-1, keepdims=True) + EPS)
    return (y * g.astype(jnp.float32)).astype(x.dtype)


def modulate(h, shift, scale):
    return h * (1 + scale) + shift


def axial_rope_tables(n):
    rows = n // GRID_W
    row = jnp.repeat(jnp.arange(rows, dtype=jnp.float32), GRID_W)
    col = jnp.tile(jnp.arange(GRID_W, dtype=jnp.float32), rows)
    n_freq = QK_ROPE // 4
    freqs = ROPE_THETA ** (-jnp.arange(n_freq, dtype=jnp.float32) / n_freq)
    ang_r = row[:, None] * freqs[None, :]
    ang_c = col[:, None] * freqs[None, :]
    ang = jnp.concatenate([ang_r, ang_r, ang_c, ang_c], axis=-1)
    return jnp.cos(ang), jnp.sin(ang)


def apply_rope(x, cos, sin):
    a1, a2, b1, b2 = jnp.split(x, 4, axis=-1)
    rot = jnp.concatenate([-a2, a1, -b2, b1], axis=-1)
    return x * cos[None, :, None, :].astype(x.dtype) + rot * sin[None, :, None, :].astype(x.dtype)


def split_proj(p):
    o1 = FOURIER_W
    o2 = o1 + Q_LORA
    o3 = o2 + KV_LORA
    o4 = o3 + QK_ROPE
    return p[..., :o1], p[..., o1:o2], p[..., o2:o3], p[..., o3:o4], p[..., o4:]


def fourier_mix(f):
    B, N, _ = f.shape
    fg = f.reshape(B, N, N_FOURIER_GROUPS, FOURIER_GROUP_W).astype(jnp.float32)
    y = jnp.fft.fft2(fg, axes=(1, 3), norm="ortho").real
    return y.reshape(B, N, FOURIER_W).astype(f.dtype)


def mla_kv(kv_lat, k_rope, kv_norm_g, w_kvb, k_gain, rope):
    B, N, _ = kv_lat.shape
    kv = (rmsnorm(kv_lat, kv_norm_g) @ w_kvb).reshape(B, N, N_HEADS, QK_NOPE + V_DIM)
    k_nope, v = kv[..., :QK_NOPE], kv[..., QK_NOPE:]
    k_r = jnp.broadcast_to(k_rope[:, :, None, :], (B, N, N_HEADS, QK_ROPE))
    k = rmsnorm(jnp.concatenate([k_nope, k_r], axis=-1), k_gain)
    if rope is not None:
        k = jnp.concatenate([k[..., :QK_NOPE], apply_rope(k[..., QK_NOPE:], *rope)], axis=-1)
    return k, v


def mla_q(q_lat, q_norm_g, w_qb, q_gain, rope):
    B, N, _ = q_lat.shape
    q = (rmsnorm(q_lat, q_norm_g) @ w_qb).reshape(B, N, N_HEADS, HEAD_QK)
    q = rmsnorm(q, q_gain)
    if rope is not None:
        q = jnp.concatenate([q[..., :QK_NOPE], apply_rope(q[..., QK_NOPE:], *rope)], axis=-1)
    return q


def latent_attention(q, k_all, v_all):
    B, S, H, Dh = q.shape
    nb = S // Q_BLOCK
    qb = q.reshape(B, nb, Q_BLOCK, H, Dh).transpose(1, 0, 2, 3, 4)
    scale = HEAD_QK ** -0.5

    def one_block(qblk):
        s = jnp.einsum('bqhd,bkhd->bhqk', qblk, k_all, preferred_element_type=jnp.float32) * scale
        p = jax.nn.softmax(s, axis=-1).astype(v_all.dtype)
        return jnp.einsum('bhqk,bkhd->bqhd', p, v_all)

    o = lax.map(one_block, qb)
    return o.transpose(1, 0, 2, 3, 4).reshape(B, S, H * V_DIM)


def context_attention(q, k, v):
    B, N = q.shape[0], q.shape[1]
    s = jnp.einsum('bqhd,bkhd->bhqk', q, k, preferred_element_type=jnp.float32) * (HEAD_QK ** -0.5)
    p = jax.nn.softmax(s, axis=-1).astype(v.dtype)
    return jnp.einsum('bhqk,bkhd->bqhd', p, v).reshape(B, N, N_HEADS * V_DIM)


def merge_branches(f_mix, att, gates, w_fourier, w_mla_o, b_gate, w_out):
    g = jax.nn.sigmoid(gates + b_gate)
    g_f, g_a = g[..., :D_MODEL], g[..., D_MODEL:]
    y = g_f * (f_mix @ w_fourier) + g_a * (att @ w_mla_o)
    return y @ w_out


def sq_relu_mlp(h, w_up, w_down):
    return jnp.square(jax.nn.relu(h @ w_up)) @ w_down


def setup_inputs(seed: int = 0) -> dict:
    key = jax.random.key(seed)
    ks = jax.random.split(key, 24)
    D, L = D_MODEL, DEPTH

    def w(k, shape, fan_in, mult=1.0):
        return jax.random.normal(k, shape, jnp.float32) * (mult * fan_in ** -0.5)

    def gain(k, shape):
        return 1.0 + 0.05 * jax.random.normal(k, shape, jnp.float32)

    return {
        "x": jax.random.normal(ks[0], (BATCH, SEQ, D), jnp.float32),
        "c": jax.random.normal(ks[1], (BATCH, D), jnp.float32),
        "ctx": jax.random.normal(ks[2], (BATCH, CTX_LEN, D), jnp.float32),
        "c_ctx": jax.random.normal(ks[3], (D,), jnp.float32),
        "ada_w": w(ks[4], (L, D, 6 * D), D, 0.5),
        "ada_b": 0.02 * jax.random.normal(ks[5], (L, 6 * D), jnp.float32),
        "norm1_g": gain(ks[6], (L, D)),
        "norm2_g": gain(ks[7], (L, D)),
        "w_in": w(ks[8], (L, D, D_IN), D),
        "b_gate": 0.02 * jax.random.normal(ks[9], (L, N_BRANCH * D), jnp.float32),
        "w_fourier": w(ks[10], (L, FOURIER_W, D), FOURIER_W),
        "q_norm_g": gain(ks[11], (L, Q_LORA)),
        "w_qb": w(ks[12], (L, Q_LORA, N_HEADS * HEAD_QK), Q_LORA),
        "kv_norm_g": gain(ks[13], (L, KV_LORA)),
        "w_kvb": w(ks[14], (L, KV_LORA, N_HEADS * (QK_NOPE + V_DIM)), KV_LORA),
        "q_gain": gain(ks[15], (L, HEAD_QK)),
        "k_gain": gain(ks[16], (L, HEAD_QK)),
        "w_mla_o": w(ks[17], (L, MLA_W, D), MLA_W),
        "w_out": w(ks[18], (L, D, D), D),
        "w_up": w(ks[19], (L, D, D_FF), D),
        "w_down": w(ks[20], (L, D_FF, D), D_FF),
    }


def reference(x, c, ctx, c_ctx, ada_w, ada_b, norm1_g, norm2_g, w_in, b_gate, w_fourier, q_norm_g, w_qb,
              kv_norm_g, w_kvb, q_gain, k_gain, w_mla_o, w_out, w_up, w_down):
    rope = axial_rope_tables(x.shape[1])
    for l in range(DEPTH):
        last = l == DEPTH - 1
        mod_x = jax.nn.silu(c) @ ada_w[l] + ada_b[l]
        sh1, sc1, g1, sh2, sc2, g2 = jnp.split(mod_x[:, None, :], 6, axis=-1)
        mod_c = jax.nn.silu(c_ctx) @ ada_w[l] + ada_b[l]
        csh1, csc1, cg1, csh2, csc2, cg2 = jnp.split(mod_c, 6, axis=-1)

        hc = modulate(rmsnorm(ctx, norm1_g[l]), csh1, csc1)
        pc = hc @ w_in[l]
        fc, qlc, kvlc, krc, gc = split_proj(pc)
        kc, vc = mla_kv(kvlc, krc, kv_norm_g[l], w_kvb[l], k_gain[l], None)

        hx = modulate(rmsnorm(x, norm1_g[l]), sh1, sc1)
        px = hx @ w_in[l]
        fx, qlx, kvlx, krx, gx = split_proj(px)
        kx, vx = mla_kv(kvlx, krx, kv_norm_g[l], w_kvb[l], k_gain[l], rope)
        qx = mla_q(qlx, q_norm_g[l], w_qb[l], q_gain[l], rope)
        att_x = latent_attention(qx, jnp.concatenate([kx, kc], axis=1), jnp.concatenate([vx, vc], axis=1))
        y_x = merge_branches(fourier_mix(fx), att_x, gx, w_fourier[l], w_mla_o[l], b_gate[l], w_out[l])

        if not last:
            qc = mla_q(qlc, q_norm_g[l], w_qb[l], q_gain[l], None)
            att_c = context_attention(qc, kc, vc)
            y_c = merge_branches(fourier_mix(fc), att_c, gc, w_fourier[l], w_mla_o[l], b_gate[l], w_out[l])
            ctx = ctx + cg1 * y_c
            hc2 = modulate(rmsnorm(ctx, norm2_g[l]), csh2, csc2)
            ctx = ctx + cg2 * sq_relu_mlp(hc2, w_up[l], w_down[l])

        x = x + g1 * y_x
        h2 = modulate(rmsnorm(x, norm2_g[l]), sh2, sc2)
        x = x + g2 * sq_relu_mlp(h2, w_up[l], w_down[l])
    return x
```

```cpp
#include <hip/hip_runtime.h>
#include <cstdio>
#include <cstdint>
namespace pg8 {
#define PG8_LAS __attribute__((address_space(3)))
typedef unsigned short bf16_t;
typedef short bf16x8 __attribute__((ext_vector_type(8)));
typedef float f32x4 __attribute__((ext_vector_type(4)));
typedef unsigned u32x4 __attribute__((ext_vector_type(4)));
constexpr int BM = 256, BK = 64, HALF = 128, HTB = HALF * BK * 2  , STAGE_BYTES = 8 * HTB, NXCD = 8, WGM = 8;

__host__ __device__ __forceinline__ int lds_byte(int r, int c) { const int st = (r >> 4) * 2 + (c >> 5), rr = r & 15, cc = c & 31, ob = rr * 64 + cc * 2; return st * 1024 + (ob ^ (((ob >> 9) & 1) << 5)); }
__host__ __device__ __forceinline__ void stage_rc(int b, int& R, int& C) { const int st = b / 1024, sb = b % 1024, swz = sb ^ (((sb >> 9) & 1) << 5); R = (st >> 1) * 16 + swz / 64; C = (st & 1) * 32 + (swz % 64) / 2; }
__host__ __device__ __forceinline__ int perm32(int rho) { const int n = rho >> 4, i = rho & 15; return 8 * (i >> 2) + 4 * n + (i & 3); }

struct Unit { int pm, pn; };
struct Gemm { const bf16_t* A; const bf16_t* Bt; int M, N, K; };

struct StaticOrder {
    int nM, nN, nwg, G, c;
    __host__ __device__ void init(int M, int N, int G_, int c_) { nM = M / BM; nN = N / BM; nwg = nM * nN; G = G_; c = c_; }
    __host__ __device__ bool next(int i, Unit& u) const {
        const long L = (long)i * G + c; if (L >= nwg) return false;
        int wgid = (int)L; { const int q = nwg / NXCD, r = nwg % NXCD, xcd = wgid % NXCD, off = wgid / NXCD; wgid = (xcd < r ? xcd * (q + 1) : r * (q + 1) + (xcd - r) * q) + off; }
        const int nig = WGM * nN, gid = wgid / nig, fm = gid * WGM, gsz = (nM - fm) < WGM ? (nM - fm) : WGM;
        u.pm = fm + ((wgid % nig) % gsz); u.pn = (wgid % nig) / gsz; return true;
    }
    __device__ __forceinline__ void a_ready(const Unit&) const {}
    __device__ __forceinline__ void done(const Unit&) const {}
};

__device__ __forceinline__ unsigned cvt_pk_bf16(float lo, float hi) { unsigned r; asm volatile("v_cvt_pk_bf16_f32 %0, %1, %2" : "=v"(r) : "v"(lo), "v"(hi)); return r; }
template <class Epi, class Sched, bool ALIGN_EPI = false, bool SP2 = false>
__device__ __forceinline__ void gemm_phase(PG8_LAS unsigned char* lds, const Gemm g, const Sched& S, const Epi& E) {
    int tid_ = threadIdx.x; asm volatile("" : "+v"(tid_)); const int tid = tid_, wid = __builtin_amdgcn_readfirstlane(tid >> 6), lane = tid & 63, wr = wid >> 2, wc = wid & 3, fr = lane & 15, fq = lane >> 4;
    const int K = g.K, nt = K / BK;
    unsigned voffA[2], voffB[2];
#pragma unroll
    for (int i = 0; i < 2; ++i) { int R, C; stage_rc(tid * 16 + i * 8192, R, C); const int Rb = Epi::PERM ? ((R & ~31) + perm32(R & 31)) : R;
        voffA[i] = (unsigned)(R * K + C) * 2u; voffB[i] = (unsigned)(Rb * K + C) * 2u; }
    const size_t kstep = (size_t)(BK * 2);
    const size_t hstep = (size_t)HALF * K * 2;
    const size_t tstep = 2 * hstep;
    const unsigned ldsw = (unsigned)wid * 1024u;
    const int aoff = lds_byte(wr * 64 + fr, fq * 8), boff = lds_byte(wc * 32 + fr, fq * 8);
#define PG8_SA(b, h) (((b) * 2 + (h)) * HTB)
#define PG8_SB(b, h) ((4 + (b) * 2 + (h)) * HTB)
#define PG8_STAGE(bufoff, gbase, voff) do { _Pragma("unroll") for (int _i = 0; _i < 2; ++_i) \
        __builtin_amdgcn_global_load_lds((const unsigned*)((const char*)(gbase) + (voff)[_i]), (PG8_LAS unsigned*)(lds + (bufoff) + ldsw + _i * 8192), 16, 0, 0); } while (0)
#define PG8_LDA(dst, b, h) do { _Pragma("unroll") for (int m = 0; m < 4; ++m) _Pragma("unroll") for (int k = 0; k < 2; ++k) dst[m][k] = *(const PG8_LAS bf16x8*)(lds + PG8_SA(b, h) + aoff + m * 2048 + k * 1024); } while (0)
#define PG8_LDB(dst, b, h) do { _Pragma("unroll") for (int n = 0; n < 2; ++n) _Pragma("unroll") for (int k = 0; k < 2; ++k) dst[n][k] = *(const PG8_LAS bf16x8*)(lds + PG8_SB(b, h) + boff + n * 2048 + k * 1024); } while (0)
#define PG8_MMA(ai, bj, At, Bt) do { __builtin_amdgcn_s_setprio(1); _Pragma("unroll") for (int m = 0; m < 4; ++m) _Pragma("unroll") for (int n = 0; n < 2; ++n) _Pragma("unroll") for (int k = 0; k < 2; ++k) \
        acc[ai][bj][m][n] = __builtin_amdgcn_mfma_f32_16x16x32_bf16(Bt[n][k], At[m][k], acc[ai][bj][m][n], 0, 0, 0); __builtin_amdgcn_s_setprio(0); } while (0)
#define PG8_WAIT_V(n) asm volatile("s_waitcnt vmcnt(" #n ")" ::: "memory")
#define PG8_WAIT_L(n) asm volatile("s_waitcnt lgkmcnt(" #n ")" ::: "memory")
#define PG8_BAR __builtin_amdgcn_s_barrier()
#define PG8_SCHED __builtin_amdgcn_sched_barrier(0)
    Unit cur, nxt; int ui = 0;
    if (!S.next(0, cur)) return;
    f32x4 acc[2][2][4][2];
#pragma unroll
    for (int a = 0; a < 2; ++a)
#pragma unroll
        for (int b = 0; b < 2; ++b)
#pragma unroll
            for (int m = 0; m < 4; ++m)
#pragma unroll
                for (int n = 0; n < 2; ++n) acc[a][b][m][n] = (f32x4){0.f, 0.f, 0.f, 0.f};
    bf16x8 At[4][2], B0[2][2], B1[2][2];
    const char* cA = (const char*)g.A + (size_t)cur.pm * tstep; const char* cB = (const char*)g.Bt + (size_t)cur.pn * tstep;
    S.a_ready(cur);
    if constexpr (SP2) {
        PG8_STAGE(PG8_SB(0, 0), cB, voffB); PG8_STAGE(PG8_SB(0, 1), cB + hstep, voffB); PG8_STAGE(PG8_SA(0, 0), cA, voffA); PG8_STAGE(PG8_SA(0, 1), cA + hstep, voffA);
        if (wr == 1) PG8_BAR;
        PG8_WAIT_V(2); PG8_BAR;
        PG8_STAGE(PG8_SB(1, 0), cB + kstep, voffB); PG8_STAGE(PG8_SA(1, 0), cA + kstep, voffA); PG8_STAGE(PG8_SB(1, 1), cB + hstep + kstep, voffB);
        PG8_WAIT_V(6); PG8_BAR;
    } else {
        PG8_STAGE(PG8_SB(0, 0), cB, voffB); PG8_STAGE(PG8_SA(0, 0), cA, voffA); PG8_STAGE(PG8_SB(0, 1), cB + hstep, voffB); PG8_STAGE(PG8_SA(0, 1), cA + hstep, voffA);
        if (wr == 1) PG8_BAR;
        PG8_WAIT_V(4); PG8_BAR;
        PG8_STAGE(PG8_SB(1, 0), cB + kstep, voffB); PG8_STAGE(PG8_SA(1, 0), cA + kstep, voffA); PG8_STAGE(PG8_SB(1, 1), cB + hstep + kstep, voffB);
        PG8_WAIT_V(6); PG8_BAR;
    }
    for (;;) {
        const bool has_next = S.next(ui + 1, nxt);
        const char* nA = has_next ? (const char*)g.A + (size_t)nxt.pm * tstep : cA; const char* nB = has_next ? (const char*)g.Bt + (size_t)nxt.pn * tstep : cB;
        for (int t = 0; t < nt; t += 2) {
            const bool last = (t == nt - 2);
            const char* a1 = cA + (size_t)(t + 1) * kstep;
            const char* a2 = last ? nA : cA + (size_t)(t + 2) * kstep; const char* b2 = last ? nB : cB + (size_t)(t + 2) * kstep;
            const char* a3 = a2 + kstep; const char* b3 = b2 + kstep;
            if (last && has_next) S.a_ready(nxt);
            if constexpr (SP2) {
            PG8_LDB(B0, 0, 0); PG8_LDB(B1, 0, 1); PG8_SCHED; PG8_LDA(At, 0, 0); PG8_STAGE(PG8_SA(1, 1), a1 + hstep, voffA);
            PG8_WAIT_V(8); PG8_WAIT_L(0); PG8_BAR; PG8_MMA(0, 0, At, B0); PG8_MMA(0, 1, At, B1); PG8_BAR; PG8_SCHED;
            PG8_LDA(At, 0, 1); PG8_STAGE(PG8_SB(0, 0), b2, voffB); PG8_STAGE(PG8_SB(0, 1), b2 + hstep, voffB); PG8_STAGE(PG8_SA(0, 0), a2, voffA);
            PG8_WAIT_V(8); PG8_WAIT_L(0); PG8_BAR; PG8_MMA(1, 0, At, B0); PG8_MMA(1, 1, At, B1); PG8_BAR; PG8_SCHED;
            PG8_LDB(B0, 1, 0); PG8_LDB(B1, 1, 1); PG8_SCHED; PG8_LDA(At, 1, 0); PG8_STAGE(PG8_SA(0, 1), a2 + hstep, voffA);
            PG8_WAIT_V(8); PG8_WAIT_L(0); PG8_BAR; PG8_MMA(0, 0, At, B0); PG8_MMA(0, 1, At, B1); PG8_BAR; PG8_SCHED;
            PG8_LDA(At, 1, 1); PG8_STAGE(PG8_SB(1, 0), b3, voffB); PG8_STAGE(PG8_SB(1, 1), b3 + hstep, voffB); PG8_STAGE(PG8_SA(1, 0), a3, voffA);
            PG8_WAIT_V(8); PG8_WAIT_L(0); PG8_BAR; PG8_MMA(1, 0, At, B0); PG8_MMA(1, 1, At, B1); PG8_BAR; PG8_SCHED;
            } else {
            PG8_LDB(B0, 0, 0); PG8_SCHED; PG8_LDA(At, 0, 0); PG8_STAGE(PG8_SA(1, 1), a1 + hstep, voffA);
            PG8_WAIT_L(8); PG8_BAR; PG8_WAIT_L(0); PG8_MMA(0, 0, At, B0); PG8_BAR; PG8_SCHED;
            PG8_LDB(B1, 0, 1); PG8_STAGE(PG8_SB(0, 0), b2, voffB);
            PG8_BAR; PG8_WAIT_L(0); PG8_MMA(0, 1, At, B1); PG8_BAR;
            PG8_LDA(At, 0, 1); PG8_STAGE(PG8_SA(0, 0), a2, voffA);
            PG8_BAR; PG8_WAIT_L(0); PG8_MMA(1, 0, At, B0); PG8_BAR; PG8_SCHED;
            PG8_STAGE(PG8_SB(0, 1), b2 + hstep, voffB);
            PG8_WAIT_V(6); PG8_BAR; PG8_MMA(1, 1, At, B1); PG8_BAR;
            PG8_LDB(B0, 1, 0); PG8_SCHED; PG8_LDA(At, 1, 0); PG8_STAGE(PG8_SA(0, 1), a2 + hstep, voffA);
            PG8_WAIT_L(8); PG8_BAR; PG8_WAIT_L(0); PG8_MMA(0, 0, At, B0); PG8_BAR; PG8_SCHED;
            PG8_LDB(B1, 1, 1); PG8_STAGE(PG8_SB(1, 0), b3, voffB);
            PG8_BAR; PG8_WAIT_L(0); PG8_MMA(0, 1, At, B1); PG8_BAR;
            PG8_LDA(At, 1, 1); PG8_STAGE(PG8_SA(1, 0), a3, voffA);
            PG8_BAR; PG8_WAIT_L(0); PG8_MMA(1, 0, At, B0); PG8_BAR; PG8_SCHED;
            PG8_STAGE(PG8_SB(1, 1), b3 + hstep, voffB);
            PG8_WAIT_V(6); PG8_BAR; PG8_MMA(1, 1, At, B1); PG8_BAR;
            }
        }
        if constexpr (ALIGN_EPI) { if (wr == 0) PG8_BAR; }
        if constexpr (!Epi::AFTER_DRAIN) { E(acc, cur, wr, wc, fr, fq); S.done(cur); }
        if (!has_next) break;
#pragma unroll
        for (int a = 0; a < 2; ++a)
#pragma unroll
            for (int b = 0; b < 2; ++b)
#pragma unroll
                for (int m = 0; m < 4; ++m)
#pragma unroll
                    for (int n = 0; n < 2; ++n) acc[a][b][m][n] = (f32x4){0.f, 0.f, 0.f, 0.f};
        cur = nxt; cA = nA; cB = nB; ++ui;
        if constexpr (ALIGN_EPI) { if (wr == 1) PG8_BAR; }
    }
    PG8_WAIT_V(0);
    if constexpr (!ALIGN_EPI) { if (wr == 0) PG8_BAR; }
    PG8_BAR;
    if constexpr (Epi::AFTER_DRAIN) { E.fused(acc, cur, wr, wc, fr, fq, lds, wid, lane); S.done(cur); }
#undef PG8_SA
#undef PG8_SB
#undef PG8_STAGE
#undef PG8_LDA
#undef PG8_LDB
#undef PG8_MMA
#undef PG8_WAIT_V
#undef PG8_WAIT_L
#undef PG8_BAR
#undef PG8_SCHED
}
}

#define GAS __attribute__((address_space(1)))
#define LAS __attribute__((address_space(3)))
typedef unsigned short bf16;
typedef unsigned v4u __attribute__((ext_vector_type(4)));
typedef unsigned v2u __attribute__((ext_vector_type(2)));
typedef float f32x4 __attribute__((ext_vector_type(4)));
typedef float f32x16 __attribute__((ext_vector_type(16)));
typedef short bf16x8 __attribute__((ext_vector_type(8)));
typedef GAS unsigned gu32;
#define RLX_AGENT __ATOMIC_RELAXED, __HIP_MEMORY_SCOPE_AGENT
#define LDS_WAIT() asm volatile("s_waitcnt lgkmcnt(0)" ::: "memory")
#define VM_WAIT() asm volatile("s_waitcnt vmcnt(0)" ::: "memory")

#ifndef MK_N_LAUNCHES
#define MK_N_LAUNCHES 1
#endif
constexpr int N_PHASES = 12;
constexpr int N_LAUNCHES = MK_N_LAUNCHES;
#define XB_TMO      128
#define XB_XCNT(j)  (256  + 64 * (j))
#define XB_XSUB(j)  (1280 + 64 * (j))
#define XB_XGEN(j)  (2304 + 64 * (j))
#define XB_TOP      3328
#define XB_TOPGEN   3392
#define XCD_BAR_WORDS 3456
#define XB_SPIN_CAP (1u << 18)

__device__ __forceinline__ unsigned xb_ld(unsigned* p)              { return __hip_atomic_load(p, __ATOMIC_RELAXED, __HIP_MEMORY_SCOPE_AGENT); }
__device__ __forceinline__ unsigned xb_add(unsigned* p, unsigned v) { return __hip_atomic_fetch_add(p, v, __ATOMIC_RELAXED, __HIP_MEMORY_SCOPE_AGENT); }
__device__ __forceinline__ unsigned xb_xcc_id() { return (unsigned)__builtin_amdgcn_s_getreg((3 << 11) | 20) & 0xFu; }
#define XB_SPIN(cond, bar) do { unsigned _sp = 0; while (cond) { __builtin_amdgcn_s_sleep(1); \
    if ((++_sp & 255u) == 0u) { if (xb_ld(&(bar)[XB_TMO])) break; if (_sp > XB_SPIN_CAP) { atomicAdd(&(bar)[XB_TMO], 1u); break; } } } } while (0)

struct XcdBarrier {
    unsigned* bar; unsigned x;
    volatile LAS unsigned* st;
};

__device__ __forceinline__ XcdBarrier xcd_barrier_post(unsigned* bar, volatile LAS unsigned* st) {
    XcdBarrier b; b.bar = bar; b.x = xb_xcc_id(); b.st = st;
    if (threadIdx.x == 0) (void)xb_add(&bar[XB_XCNT(b.x)], 1u);
    return b;
}
__device__ __forceinline__ void xcd_barrier_complete(unsigned* bar, unsigned x, unsigned& nloc, unsigned& nx) {
    const unsigned G = gridDim.x * gridDim.y * gridDim.z;
    unsigned sum, cnt, mine, sp = 0u;
    for (;;) {
        sum = 0u; cnt = 0u; mine = 0u;
#pragma unroll
        for (unsigned j = 0; j < 16; ++j) { const unsigned c = xb_ld(&bar[XB_XCNT(j)]); sum += c; cnt += (c > 0u) ? 1u : 0u; mine = (j == x) ? c : mine; }
        if (sum == G) break;
        __builtin_amdgcn_s_sleep(1);
        if ((++sp & 255u) == 0u) { if (xb_ld(&bar[XB_TMO])) break; if (sp > XB_SPIN_CAP) { atomicAdd(&bar[XB_TMO], 1u); break; } }
    }
    nloc = mine > 0u ? mine : 1u; nx = cnt > 0u ? cnt : 1u;
}

__device__ __forceinline__ void xcd_barrier(const XcdBarrier& b) {
    asm volatile("s_waitcnt vmcnt(0)" ::: "memory");
    __syncthreads();
    if (threadIdx.x == 0) {
        unsigned* bar = b.bar;
        __builtin_amdgcn_s_waitcnt(0);
        unsigned nloc = b.st[0], nx = b.st[1];
        if (nloc == 0u) { xcd_barrier_complete(bar, b.x, nloc, nx); b.st[0] = nloc; b.st[1] = nx; }
        const unsigned old = xb_add(&bar[XB_XSUB(b.x)], 1u);
        const unsigned gen = old / nloc;
        if (old + 1u == (gen + 1u) * nloc) {
            __builtin_amdgcn_fence(__ATOMIC_RELEASE, "agent");
            asm volatile("s_waitcnt vmcnt(0)" ::: "memory");
            const unsigned og = xb_add(&bar[XB_TOP], 1u);
            const unsigned tg = og / nx;
            if (og + 1u == (tg + 1u) * nx) xb_add(&bar[XB_TOPGEN], 1u);
            else XB_SPIN(xb_ld(&bar[XB_TOPGEN]) == tg, bar);
            __builtin_amdgcn_fence(__ATOMIC_ACQUIRE, "agent");
            xb_add(&bar[XB_XGEN(b.x)], 1u);
            asm volatile("s_waitcnt vmcnt(0)" ::: "memory");
        } else {
            XB_SPIN(xb_ld(&bar[XB_XGEN(b.x)]) == gen, bar);
            __builtin_amdgcn_fence(__ATOMIC_ACQUIRE, "agent");
            asm volatile("s_waitcnt vmcnt(0)" ::: "memory");
        }
    }
    __syncthreads();
}

constexpr int NB = 4, SEQ = 4096, DM = 1024, MT = NB * SEQ, CTXL = 256, CT = NB * CTXL, MA = MT + CT;
constexpr int NH = 8, DQK = 96, DV = 64, NKEY = SEQ + CTXL;
constexpr int DIN = 2976, DINP = 3072, DFF = 4096;
constexpr float EPS = 1e-6f;
constexpr float QSCALE = 0.10206207261596575f * 1.4426950408889634f;
constexpr float DFT_NORM = 0.0013810679320049757f;

constexpr size_t MiB = 1u << 20;
constexpr size_t WS_CTL = 0, CTL_ZERO_BYTES = 1 * MiB;
constexpr size_t WS_PART = 1 * MiB;
constexpr size_t WS_MOD = 3 * MiB;
constexpr size_t WS_WIN = 4 * MiB;
constexpr size_t WS_WQB = 10 * MiB;
constexpr size_t WS_WKVB = 10 * MiB + 512 * 1024;
constexpr size_t WS_WF = 11 * MiB;
constexpr size_t WS_WMO = 13 * MiB;
constexpr size_t WS_WOUT = 14 * MiB;
constexpr size_t WS_DFT = 16 * MiB;
constexpr size_t WS_HX = 50 * MiB;
constexpr size_t WS_FT = 84 * MiB;
constexpr size_t WS_QL = 100 * MiB;
constexpr size_t WS_KVK = 108 * MiB;
constexpr size_t WS_ATT = 100 * MiB;
constexpr size_t WS_GATES = 117 * MiB;
constexpr size_t WS_QR = 181 * MiB;
constexpr size_t WS_VT = 205 * MiB;
constexpr size_t WS_KF = 222 * MiB;
constexpr size_t WS_Y = 181 * MiB;
constexpr size_t WS_WUP = 216 * MiB;
constexpr size_t WS_WDOWN = 224 * MiB;
constexpr size_t WS_U = 82 * MiB;
constexpr size_t WS_END = 256 * MiB;
static_assert(WS_KF + (size_t)NB * NH * NKEY * DQK * 2 <= 248 * MiB && WS_U + (size_t)MT * DFF * 2 <= WS_WUP, "ws map");

constexpr int CW_TMO = 0;
constexpr int CW_BAR = 4096;
constexpr int CW_ATTQ = 8192;

constexpr int RING_OFF = 0, RING_BYTES = 131072;
constexpr int LDSCTL_OFF = RING_BYTES, MISC_OFF = LDSCTL_OFF + 320, TAB_OFF = RING_BYTES + 1024;
constexpr int LDS_BYTES = 147456;

__device__ __forceinline__ float bflo(unsigned w) { return __uint_as_float(w << 16); }
__device__ __forceinline__ float bfhi(unsigned w) { return __uint_as_float(w & 0xffff0000u); }
__device__ __forceinline__ float bf2f(bf16 b) { return __uint_as_float((unsigned)b << 16); }
typedef float f32x2_t __attribute__((ext_vector_type(2))); typedef __bf16 bf16x2_t __attribute__((ext_vector_type(2)));
__device__ __forceinline__ unsigned pk2(float lo, float hi) { f32x2_t v = {lo, hi}; bf16x2_t b = __builtin_convertvector(v, bf16x2_t); return __builtin_bit_cast(unsigned, b); }
__device__ __forceinline__ v4u pk8(const f32x4 a, const f32x4 b) { v4u w; w.x = pk2(a[0], a[1]); w.y = pk2(a[2], a[3]); w.z = pk2(b[0], b[1]); w.w = pk2(b[2], b[3]); return w; }
__device__ __forceinline__ float wave_sum(float v) {
#pragma unroll
    for (int o = 1; o < 64; o <<= 1) v += __shfl_xor(v, o);
    return v;
}
__device__ __forceinline__ float sigmoidf_fast(float x) { return __builtin_amdgcn_rcpf(1.0f + __builtin_amdgcn_exp2f(-1.4426950408889634f * x)); }

#define EPI_IDS() int t__ = threadIdx.x; asm volatile("" : "+v"(t__)); const int fr = t__ & 15, fq = (t__ >> 4) & 3, wid__ = __builtin_amdgcn_readfirstlane(t__ >> 6), wr = wid__ >> 2, wc = wid__ & 3; (void)wr_; (void)wc_; (void)fr_; (void)fq_
typedef const pg8::f32x4 (&AccRef)[2][2][4][2];
struct OneUnit { int pm, pn;
    __device__ __forceinline__ bool next(int i, pg8::Unit& u) const { if (i != 0) return false; u.pm = pm; u.pn = pn; return true; }
    __device__ __forceinline__ void a_ready(const pg8::Unit&) const {}
    __device__ __forceinline__ void done(const pg8::Unit&) const {}
};
__device__ __forceinline__ void row_to_bkey(int row, int& b, int& key) {
    if (row < MT) { b = row >> 12; key = row & 4095; } else { const int rr = row - MT; b = rr >> 8; key = SEQ + (rr & 255); }
}

struct EpiInProj {
    static constexpr bool PERM = true, AFTER_DRAIN = false;
    bf16 *FT, *QL, *KVK, *GATES; const float* b_gate;
    __device__ __forceinline__ void operator()(AccRef acc, const pg8::Unit& u, int wr_, int wc_, int fr_, int fq_) const {
        EPI_IDS();
        const int row0 = u.pm * 256 + wr * 64 + fr, cw = wc * 32 + 8 * fq;
        if (u.pn < 2) {
#pragma unroll
            for (int ai = 0; ai < 2; ++ai)
#pragma unroll
                for (int m = 0; m < 4; ++m) { const int row = row0 + ai * 128 + m * 16; const int b = row >> 12, n = row & 4095;
#pragma unroll
                    for (int bj = 0; bj < 2; ++bj) { const int c0 = u.pn * 256 + bj * 128 + cw; bf16* p = FT + (((size_t)(b * 512 + c0)) << 12) + n;
                        const v4u w = pk8(acc[ai][bj][m][0], acc[ai][bj][m][1]);
                        p[0 * 4096] = (bf16)(w.x & 0xffffu); p[1 * 4096] = (bf16)(w.x >> 16); p[2 * 4096] = (bf16)(w.y & 0xffffu); p[3 * 4096] = (bf16)(w.y >> 16);
                        p[4 * 4096] = (bf16)(w.z & 0xffffu); p[5 * 4096] = (bf16)(w.z >> 16); p[6 * 4096] = (bf16)(w.w & 0xffffu); p[7 * 4096] = (bf16)(w.w >> 16); } }
        } else if (u.pn < 4) {
            bf16* base = (u.pn == 2) ? QL : KVK;
#pragma unroll
            for (int ai = 0; ai < 2; ++ai)
#pragma unroll
                for (int m = 0; m < 4; ++m) { const int row = row0 + ai * 128 + m * 16;
#pragma unroll
                    for (int bj = 0; bj < 2; ++bj) *(v4u*)(base + (size_t)row * 256 + bj * 128 + cw) = pk8(acc[ai][bj][m][0], acc[ai][bj][m][1]); }
        } else {
            const int gc = (u.pn - 4) * 256 + cw;
#pragma unroll
            for (int bj = 0; bj < 2; ++bj) { const f32x4 b0 = *(const f32x4*)(b_gate + gc + bj * 128), b1 = *(const f32x4*)(b_gate + gc + bj * 128 + 4);
#pragma unroll
                for (int ai = 0; ai < 2; ++ai)
#pragma unroll
                    for (int m = 0; m < 4; ++m) { const int row = row0 + ai * 128 + m * 16; f32x4 v0 = acc[ai][bj][m][0] + b0, v1 = acc[ai][bj][m][1] + b1;
#pragma unroll
                        for (int e = 0; e < 4; ++e) { v0[e] = sigmoidf_fast(v0[e]); v1[e] = sigmoidf_fast(v1[e]); }
                        *(v4u*)(GATES + (size_t)row * 2048 + gc + bj * 128) = pk8(v0, v1); } }
        }
    }
};
template <int ACT  > struct EpiStore {
    static constexpr bool PERM = true, AFTER_DRAIN = false;
    bf16* O; int ldc;
    __device__ __forceinline__ void operator()(AccRef acc, const pg8::Unit& u, int wr_, int wc_, int fr_, int fq_) const {
        EPI_IDS();
        const int row0 = u.pm * 256 + wr * 64 + fr, c0 = u.pn * 256 + wc * 32 + 8 * fq;
#pragma unroll
        for (int ai = 0; ai < 2; ++ai)
#pragma unroll
            for (int m = 0; m < 4; ++m) { bf16* rp = O + (size_t)(row0 + ai * 128 + m * 16) * ldc + c0;
#pragma unroll
                for (int bj = 0; bj < 2; ++bj) { f32x4 v0 = acc[ai][bj][m][0], v1 = acc[ai][bj][m][1];
                    if (ACT == 1) {
#pragma unroll
                        for (int e = 0; e < 4; ++e) { const float a = fmaxf(v0[e], 0.f), b = fmaxf(v1[e], 0.f); v0[e] = a * a; v1[e] = b * b; } }
                    *(v4u*)(rp + bj * 128) = pk8(v0, v1); } }
    }
};
struct EpiKvUp {
    static constexpr bool PERM = true, AFTER_DRAIN = false;
    const bf16* KVK; bf16 *KF, *VT;
    __device__ __forceinline__ void operator()(AccRef acc, const pg8::Unit& u, int wr_, int wc_, int fr_, int fq_) const {
        EPI_IDS();
        const int row0 = u.pm * 256 + wr * 64 + fr;
#pragma unroll
        for (int ai = 0; ai < 2; ++ai)
#pragma unroll
            for (int m = 0; m < 4; ++m) { const int row = row0 + ai * 128 + m * 16;
                const v4u* kp = (const v4u*)(KVK + (size_t)row * 256 + fq * 32); float s = 0.f;
#pragma unroll
                for (int i = 0; i < 4; ++i) { const v4u w = kp[i];
                    s += bflo(w.x) * bflo(w.x) + bfhi(w.x) * bfhi(w.x) + bflo(w.y) * bflo(w.y) + bfhi(w.y) * bfhi(w.y)
                       + bflo(w.z) * bflo(w.z) + bfhi(w.z) * bfhi(w.z) + bflo(w.w) * bflo(w.w) + bfhi(w.w) * bfhi(w.w); }
                s += __shfl_xor(s, 16); s += __shfl_xor(s, 32);
                const float rs = __builtin_amdgcn_rsqf(s * (1.0f / 128.0f) + EPS);
                int b, key; row_to_bkey(row, b, key);
#pragma unroll
                for (int bj = 0; bj < 2; ++bj) { const int head = 2 * u.pn + bj; const f32x4 v0 = acc[ai][bj][m][0] * rs, v1 = acc[ai][bj][m][1] * rs; const v4u w = pk8(v0, v1);
                    if (wc < 2) { *(v4u*)(KF + ((size_t)((b * NH + head) * NKEY + key)) * DQK + wc * 32 + 8 * fq) = w; }
                    else { bf16* p = VT + ((size_t)((b * NH + head) * DV + (wc - 2) * 32 + 8 * fq)) * NKEY + key;
                        p[0 * NKEY] = (bf16)(w.x & 0xffffu); p[1 * NKEY] = (bf16)(w.x >> 16); p[2 * NKEY] = (bf16)(w.y & 0xffffu); p[3 * NKEY] = (bf16)(w.y >> 16);
                        p[4 * NKEY] = (bf16)(w.z & 0xffffu); p[5 * NKEY] = (bf16)(w.z >> 16); p[6 * NKEY] = (bf16)(w.w & 0xffffu); p[7 * NKEY] = (bf16)(w.w >> 16); } }
                asm volatile("" ::: "memory"); }
    }
};
struct EpiDft {
    static constexpr bool PERM = true, AFTER_DRAIN = false;
    bf16* PM; int b;
    __device__ __forceinline__ void operator()(AccRef acc, const pg8::Unit& u, int wr_, int wc_, int fr_, int fq_) const {
        EPI_IDS();
        const int row0 = u.pm * 256 + wr * 64 + fr;
#pragma unroll
        for (int ai = 0; ai < 2; ++ai)
#pragma unroll
            for (int m = 0; m < 4; ++m) { const int row = row0 + ai * 128 + m * 16; const int s = row >> 11, np = row & 2047;
#pragma unroll
                for (int bj = 0; bj < 2; ++bj) { const int dc = (2 * u.pn + bj) * 256 + s * 128 + wc * 32 + 8 * fq;
                    const f32x4 v0 = acc[ai][bj][m][0], v1 = acc[ai][bj][m][1];
                    *(v4u*)(PM + ((size_t)(b * SEQ + np)) * 1024 + dc) = pk8(v0, v1);
                    if (np != 0) { const float sg = s ? -1.f : 1.f; *(v4u*)(PM + ((size_t)(b * SEQ + SEQ - np)) * 1024 + dc) = pk8(v0 * sg, v1 * sg); } } }
    }
};
struct EpiMerge1 {
    static constexpr bool PERM = true, AFTER_DRAIN = false;
    const bf16* GATES; bf16* Y;
    __device__ __forceinline__ void operator()(AccRef acc, const pg8::Unit& u, int wr_, int wc_, int fr_, int fq_) const {
        EPI_IDS();
        const int row0 = u.pm * 256 + wr * 64 + fr, c0 = u.pn * 256 + wc * 32 + 8 * fq;
#pragma unroll
        for (int ai = 0; ai < 2; ++ai)
#pragma unroll
            for (int m = 0; m < 4; ++m) { const int row = row0 + ai * 128 + m * 16;
#pragma unroll
                for (int bj = 0; bj < 2; ++bj) { const v4u g = *(const v4u*)(GATES + (size_t)row * 2048 + c0 + bj * 128);
                    f32x4 v0 = acc[ai][bj][m][0], v1 = acc[ai][bj][m][1];
                    v0[0] *= bflo(g.x); v0[1] *= bfhi(g.x); v0[2] *= bflo(g.y); v0[3] *= bfhi(g.y); v1[0] *= bflo(g.z); v1[1] *= bfhi(g.z); v1[2] *= bflo(g.w); v1[3] *= bfhi(g.w);
                    *(v4u*)(Y + (size_t)row * 1024 + c0 + bj * 128) = pk8(v0, v1); }
                if (m & 1) asm volatile("" ::: "memory"); }
    }
};
struct EpiMerge2 {
    static constexpr bool PERM = true, AFTER_DRAIN = false;
    const bf16* GATES; bf16* Y;
    __device__ __forceinline__ void operator()(AccRef acc, const pg8::Unit& u, int wr_, int wc_, int fr_, int fq_) const {
        EPI_IDS();
        const int row0 = u.pm * 256 + wr * 64 + fr, c0 = u.pn * 256 + wc * 32 + 8 * fq;
#pragma unroll
        for (int ai = 0; ai < 2; ++ai)
#pragma unroll
            for (int m = 0; m < 4; ++m) { const int row = row0 + ai * 128 + m * 16;
#pragma unroll
                for (int bj = 0; bj < 2; ++bj) { const v4u g = *(const v4u*)(GATES + (size_t)row * 2048 + 1024 + c0 + bj * 128);
                    bf16* yp = Y + (size_t)row * 1024 + c0 + bj * 128; const v4u t = *(const v4u*)yp;
                    f32x4 v0 = acc[ai][bj][m][0], v1 = acc[ai][bj][m][1];
                    v0[0] = v0[0] * bflo(g.x) + bflo(t.x); v0[1] = v0[1] * bfhi(g.x) + bfhi(t.x); v0[2] = v0[2] * bflo(g.y) + bflo(t.y); v0[3] = v0[3] * bfhi(g.y) + bfhi(t.y);
                    v1[0] = v1[0] * bflo(g.z) + bflo(t.z); v1[1] = v1[1] * bfhi(g.z) + bfhi(t.z); v1[2] = v1[2] * bflo(g.w) + bflo(t.w); v1[3] = v1[3] * bfhi(g.w) + bfhi(t.w);
                    *(v4u*)yp = pk8(v0, v1); }
                if (m & 1) asm volatile("" ::: "memory"); }
    }
};
struct EpiResid {
    static constexpr bool PERM = false, AFTER_DRAIN = false;
    const float* base; float* out; const float* gate;
    __device__ __forceinline__ void operator()(AccRef acc, const pg8::Unit& u, int wr_, int wc_, int fr_, int fq_) const {
        EPI_IDS();
        const int row0 = u.pm * 256 + wr * 64 + fr, c0 = u.pn * 256 + wc * 32 + 4 * fq; const int b = (u.pm * 256) >> 12;
        f32x4 gv[2][2];
#pragma unroll
        for (int bj = 0; bj < 2; ++bj)
#pragma unroll
            for (int n = 0; n < 2; ++n) gv[bj][n] = *(const f32x4*)(gate + (size_t)b * 6144 + c0 + bj * 128 + n * 16);
#pragma unroll
        for (int ai = 0; ai < 2; ++ai)
#pragma unroll
            for (int m = 0; m < 4; ++m) { const size_t off = (size_t)(row0 + ai * 128 + m * 16) * 1024 + c0;
#pragma unroll
                for (int bj = 0; bj < 2; ++bj)
#pragma unroll
                    for (int n = 0; n < 2; ++n) { const f32x4 bs = *(const f32x4*)(base + off + bj * 128 + n * 16);
                        *(f32x4*)(out + off + bj * 128 + n * 16) = bs + gv[bj][n] * acc[ai][bj][m][n]; }
                if (m & 1) asm volatile("" ::: "memory"); }
    }
};

struct Args;
struct Frame {
    LAS unsigned char* lds;
    volatile LAS unsigned* MISC;
    gu32* ctl;
    int tid, lane, wave, vcu, G, bx;
    unsigned char* ws;
    const __attribute__((address_space(4))) struct Args* ap;
};
struct Args { const float* in[21]; float* out; unsigned char* ws; int ph_lo, ph_hi, li, pad; };

__device__ __forceinline__ void transpose_item(const float* W, int K, int N, bf16* WT, int ldk, int drow, const float* rs, LAS float* scr, int kb, int nb, int lane) {
    const int k0 = 64 * kb, n0 = 32 * nb;
#pragma unroll 8
    for (int i = 0; i < 32; ++i) { const int kk = 2 * i + (lane >> 5); scr[kk * 33 + (lane & 31)] = W[(size_t)(k0 + kk) * N + n0 + (lane & 31)]; }
    LDS_WAIT(); asm volatile("" ::: "memory");
    const int c = lane & 7;
    float sc[8];
#pragma unroll
    for (int e = 0; e < 8; ++e) sc[e] = rs ? rs[k0 + 8 * c + e] : 1.0f;
#pragma unroll
    for (int j = 0; j < 4; ++j) { const int n = (lane >> 3) + 8 * j; const LAS float* s = scr + (8 * c) * 33 + n;
        v4u o; o.x = pk2(s[0 * 33] * sc[0], s[1 * 33] * sc[1]); o.y = pk2(s[2 * 33] * sc[2], s[3 * 33] * sc[3]); o.z = pk2(s[4 * 33] * sc[4], s[5 * 33] * sc[5]); o.w = pk2(s[6 * 33] * sc[6], s[7 * 33] * sc[7]);
        *(GAS v4u*)(WT + (size_t)(drow + n0 + n) * ldk + k0 + 8 * c) = o; }
    LDS_WAIT(); asm volatile("" ::: "memory");
}
__device__ __forceinline__ float silu_f(float x) { return x / (1.0f + __expf(-x)); }
__device__ __forceinline__ void ada_item(const float* c, const float* c_ctx, const float* ada_w, float* PART, int item, int lane) {
    const int cg = item % 96, kc = item / 96, col = cg * 64 + lane, k0 = kc * 64;
    float s[5], a[5];
#pragma unroll
    for (int r = 0; r < 4; ++r) s[r] = silu_f(c[r * 1024 + k0 + lane]);
    s[4] = silu_f(c_ctx[k0 + lane]);
#pragma unroll
    for (int r = 0; r < 5; ++r) a[r] = 0.f;
    const float* wp = ada_w + (size_t)k0 * 6144 + col;
#pragma unroll 16
    for (int kk = 0; kk < 64; ++kk) { const float w = wp[(size_t)kk * 6144];
#pragma unroll
        for (int r = 0; r < 5; ++r) a[r] += __shfl(s[r], kk) * w; }
#pragma unroll
    for (int r = 0; r < 5; ++r) PART[(size_t)(kc * 5 + r) * 6144 + col] = a[r];
}
__device__ __forceinline__ void wf_item(const float* wf, bf16* WFT, const LAS float* tab, int item, int lane) {
    const int cb = item & 15, jb = (item >> 4) & 15, g = item >> 8; const int j = jb * 64 + lane, cbase = cb * 8;
    float ac[8], as[8];
#pragma unroll
    for (int i = 0; i < 8; ++i) { ac[i] = 0.f; as[i] = 0.f; }
    const float* wp = wf + (size_t)(g * 128) * 1024 + j;
    for (int cp = 0; cp < 128; ++cp) { const float w = wp[(size_t)cp * 1024];
#pragma unroll
        for (int i = 0; i < 8; ++i) { const int idx = ((cbase + i) * cp) & 127; ac[i] += tab[idx] * w; as[i] += tab[128 + idx] * w; } }
    bf16* op = WFT + (size_t)j * 1024 + g * 256 + cbase;
    v4u o; o.x = pk2(ac[0] * DFT_NORM, ac[1] * DFT_NORM); o.y = pk2(ac[2] * DFT_NORM, ac[3] * DFT_NORM); o.z = pk2(ac[4] * DFT_NORM, ac[5] * DFT_NORM); o.w = pk2(ac[6] * DFT_NORM, ac[7] * DFT_NORM);
    *(v4u*)op = o;
    o.x = pk2(-as[0] * DFT_NORM, -as[1] * DFT_NORM); o.y = pk2(-as[2] * DFT_NORM, -as[3] * DFT_NORM); o.z = pk2(-as[4] * DFT_NORM, -as[5] * DFT_NORM); o.w = pk2(-as[6] * DFT_NORM, -as[7] * DFT_NORM);
    *(v4u*)(op + 128) = o;
}
__device__ __forceinline__ void dft_item(bf16* DFT, int item, int lane) {
    const int chunk = item * 64 + lane; const int m = chunk >> 9, n0 = (chunk & 511) * 8; const int s = m >> 11, np = m & 2047;
    float v[8];
#pragma unroll
    for (int e = 0; e < 8; ++e) { const int idx = (np * (n0 + e)) & 4095; const float t = (float)idx * (1.0f / 4096.0f); v[e] = s ? __builtin_amdgcn_sinf(t) : __builtin_amdgcn_cosf(t); }
    v4u o; o.x = pk2(v[0], v[1]); o.y = pk2(v[2], v[3]); o.z = pk2(v[4], v[5]); o.w = pk2(v[6], v[7]);
    *(v4u*)(DFT + (size_t)m * 4096 + n0) = o;
}

__device__ __forceinline__ void p0_prep(Frame& F) {
    LAS float* tab = (LAS float*)(F.lds + TAB_OFF);
    if (F.tid < 128) { const float t = (float)F.tid * (1.0f / 128.0f); tab[F.tid] = __builtin_amdgcn_cosf(t); tab[128 + F.tid] = __builtin_amdgcn_sinf(t); }
    __syncthreads();
    LAS float* scr = (LAS float*)(F.lds + RING_OFF + F.wave * 16384);
    const int gw = F.vcu * 8 + F.wave, NGW = F.G * 8;
    unsigned char* ws = F.ws;
    constexpr int I_ADA = 96 * 16, I_WIN = 16 * 93, I_WQB = 4 * 24, I_WKVB = 2 * 32, I_WMO = 8 * 32, I_WOUT = 16 * 32, I_WF = 1024, I_Z1 = 192, I_Z2 = 256, I_DFT = 32768;
    constexpr int NIT = I_ADA + I_WIN + I_WQB + I_WKVB + I_WMO + I_WOUT + I_WF + I_Z1 + I_Z2 + I_DFT;
    for (int it = gw; it < NIT; it += NGW) {
        int r = it;
#ifdef DBG_P0_LO
        if (it < DBG_P0_LO || it >= DBG_P0_HI) continue;
#endif
        if (r < I_ADA) { ada_item(F.ap->in[1], F.ap->in[3], F.ap->in[4], (float*)(ws + WS_PART), r, F.lane); continue; } r -= I_ADA;
        if (r < I_WIN) { const int kb = r / 93, nb = r % 93; const int n0 = nb * 32; const int drow = (n0 < 928) ? 0 : 96;
            transpose_item(F.ap->in[8], 1024, DIN, (bf16*)(ws + WS_WIN), 1024, drow, nullptr, scr, kb, nb, F.lane); continue; } r -= I_WIN;
        if (r < I_WQB) { transpose_item(F.ap->in[12], 256, 768, (bf16*)(ws + WS_WQB), 256, 0, F.ap->in[11], scr, r / 24, r % 24, F.lane); continue; } r -= I_WQB;
        if (r < I_WKVB) { transpose_item(F.ap->in[14], 128, 1024, (bf16*)(ws + WS_WKVB), 256, 0, F.ap->in[13], scr, r / 32, r % 32, F.lane); continue; } r -= I_WKVB;
        if (r < I_WMO) { transpose_item(F.ap->in[17], 512, 1024, (bf16*)(ws + WS_WMO), 512, 0, nullptr, scr, r / 32, r % 32, F.lane); continue; } r -= I_WMO;
        if (r < I_WOUT) { transpose_item(F.ap->in[18], 1024, 1024, (bf16*)(ws + WS_WOUT), 1024, 0, nullptr, scr, r / 32, r % 32, F.lane); continue; } r -= I_WOUT;
        if (r < I_WF) { wf_item(F.ap->in[10], (bf16*)(ws + WS_WF), tab, r, F.lane); continue; } r -= I_WF;
        if (r < I_Z1) { const int ch = r * 64 + F.lane; *(v4u*)(ws + WS_WIN + (size_t)928 * 2048 + (size_t)ch * 16) = (v4u){0u, 0u, 0u, 0u}; continue; } r -= I_Z1;
        if (r < I_Z2) { const int ch = r * 64 + F.lane; *(v4u*)(ws + WS_WKVB + (size_t)(ch >> 4) * 512 + 256 + (ch & 15) * 16) = (v4u){0u, 0u, 0u, 0u}; continue; } r -= I_Z2;
        dft_item((bf16*)(ws + WS_DFT), r, F.lane);
    }
}
__device__ __forceinline__ void p1_mod(Frame& F) {
    const float* PART = (const float*)(F.ws + WS_PART); float* MOD = (float*)(F.ws + WS_MOD);
    for (int o = F.vcu * 512 + F.tid; o < 5 * 6144; o += F.G * 512) { const int j = o % 6144, r = o / 6144; float v = F.ap->in[5][j];
#pragma unroll
        for (int kc = 0; kc < 16; ++kc) v += PART[(size_t)(kc * 5 + r) * 6144 + j];
        MOD[o] = v; }
}
__device__ __forceinline__ void norm_mod_row(const float* xrow, const float* g, const float* sh, const float* sc, bf16* orow, int lane) {
    const f32x4* xr = (const f32x4*)xrow + lane;
    f32x4 v[4]; float s = 0.f;
#pragma unroll
    for (int j = 0; j < 4; ++j) { v[j] = xr[64 * j]; s += (v[j].x * v[j].x + v[j].y * v[j].y) + (v[j].z * v[j].z + v[j].w * v[j].w); }
    const float rstd = __builtin_amdgcn_rsqf(wave_sum(s) * (1.0f / 1024.0f) + EPS);
    unsigned long long* o8 = (unsigned long long*)orow + lane;
#pragma unroll
    for (int j = 0; j < 4; ++j) { const f32x4 gg = ((const f32x4*)g)[64 * j + lane], hh = ((const f32x4*)sh)[64 * j + lane], cc = ((const f32x4*)sc)[64 * j + lane];
        const f32x4 y = (v[j] * rstd * gg) * (cc + 1.0f) + hh;
        o8[64 * j] = (unsigned long long)pk2(y.x, y.y) | ((unsigned long long)pk2(y.z, y.w) << 32); }
}
__device__ __forceinline__ void p9_weights(Frame& F) {
    LAS float* scr = (LAS float*)(F.lds + RING_OFF + F.wave * 16384);
    const int gw = F.vcu * 8 + F.wave, NGW = F.G * 8;
    constexpr int I_UP = 16 * 128, I_DN = 64 * 32;
    for (int it = gw; it < I_UP + I_DN; it += NGW) {
        if (it < I_UP) transpose_item(F.ap->in[19], 1024, 4096, (bf16*)(F.ws + WS_WUP), 1024, 0, nullptr, scr, it / 128, it % 128, F.lane);
        else { const int r = it - I_UP; transpose_item(F.ap->in[20], 4096, 1024, (bf16*)(F.ws + WS_WDOWN), 4096, 0, nullptr, scr, r / 32, r % 32, F.lane); }
    }
}

__device__ __forceinline__ void rope_cs(int n, int l8, float& cr, float& sr, float& cc, float& sc) {
    const float fr8[8] = {1.0f, 0.31622776601683794f, 0.1f, 0.031622776601683794f, 0.01f, 0.0031622776601683794f, 0.001f, 0.00031622776601683794f};
    float f = fr8[0];
#pragma unroll
    for (int i = 1; i < 8; ++i) f = (l8 == i) ? fr8[i] : f;
    const float INV2PI = 0.15915494309189535f;
    const float ar = (float)(n >> 6) * f * INV2PI, ac = (float)(n & 63) * f * INV2PI;
    const float arf = ar - floorf(ar), acf = ac - floorf(ac);
    cr = __builtin_amdgcn_cosf(arf); sr = __builtin_amdgcn_sinf(arf); cc = __builtin_amdgcn_cosf(acf); sc = __builtin_amdgcn_sinf(acf);
}
__device__ __forceinline__ float sumsq8(const v4u w) {
    return bflo(w.x) * bflo(w.x) + bfhi(w.x) * bfhi(w.x) + bflo(w.y) * bflo(w.y) + bfhi(w.y) * bfhi(w.y)
         + bflo(w.z) * bflo(w.z) + bfhi(w.z) * bfhi(w.z) + bflo(w.w) * bflo(w.w) + bfhi(w.w) * bfhi(w.w);
}
__device__ __forceinline__ void finalize_row(Frame& F, int row) {
    const int lane = F.lane, h = lane >> 3, l8 = lane & 7;
    bf16* KF = (bf16*)(F.ws + WS_KF); const bf16* KVK = (const bf16*)(F.ws + WS_KVK); bf16* QR = (bf16*)(F.ws + WS_QR); const bf16* QL = (const bf16*)(F.ws + WS_QL);
    const float* q_gain = F.ap->in[15]; const float* k_gain = F.ap->in[16];
    int b, key; row_to_bkey(row, b, key);
    const bool lat = row < MT;
    float cr = 1.f, sr = 0.f, cc = 1.f, sc = 0.f;
    if (lat) rope_cs(key, l8, cr, sr, cc, sc);
    {
        bf16* kp = KF + ((size_t)((b * NH + h) * NKEY + key)) * DQK;
        const v4u kv = *(const v4u*)(kp + 8 * l8);
        const bf16* krp = KVK + (size_t)row * 256 + 128;
        float a1 = bf2f(krp[l8]), a2 = bf2f(krp[8 + l8]), b1 = bf2f(krp[16 + l8]), b2 = bf2f(krp[24 + l8]);
        float ss = sumsq8(kv) + a1 * a1 + a2 * a2 + b1 * b1 + b2 * b2;
        ss += __shfl_xor(ss, 1); ss += __shfl_xor(ss, 2); ss += __shfl_xor(ss, 4);
        const float rk = __builtin_amdgcn_rsqf(ss * (1.0f / 96.0f) + EPS);
        const f32x4 g0 = *(const f32x4*)(k_gain + 8 * l8), g1 = *(const f32x4*)(k_gain + 8 * l8 + 4);
        v4u o; o.x = pk2(bflo(kv.x) * rk * g0[0], bfhi(kv.x) * rk * g0[1]); o.y = pk2(bflo(kv.y) * rk * g0[2], bfhi(kv.y) * rk * g0[3]);
        o.z = pk2(bflo(kv.z) * rk * g1[0], bfhi(kv.z) * rk * g1[1]); o.w = pk2(bflo(kv.w) * rk * g1[2], bfhi(kv.w) * rk * g1[3]);
        *(v4u*)(kp + 8 * l8) = o;
        a1 *= rk * k_gain[64 + l8]; a2 *= rk * k_gain[72 + l8]; b1 *= rk * k_gain[80 + l8]; b2 *= rk * k_gain[88 + l8];
        const float oa1 = a1 * cr - a2 * sr, oa2 = a2 * cr + a1 * sr, ob1 = b1 * cc - b2 * sc, ob2 = b2 * cc + b1 * sc;
        const unsigned w0 = pk2(oa1, oa2), w1 = pk2(ob1, ob2);
        kp[64 + l8] = (bf16)(w0 & 0xffffu); kp[72 + l8] = (bf16)(w0 >> 16); kp[80 + l8] = (bf16)(w1 & 0xffffu); kp[88 + l8] = (bf16)(w1 >> 16);
    }
    if (lat) {
        const v2u qw = *(const v2u*)(QL + (size_t)row * 256 + 4 * lane);
        float sq = bflo(qw.x) * bflo(qw.x) + bfhi(qw.x) * bfhi(qw.x) + bflo(qw.y) * bflo(qw.y) + bfhi(qw.y) * bfhi(qw.y);
        const float aq = __builtin_amdgcn_rsqf(wave_sum(sq) * (1.0f / 256.0f) + EPS);
        bf16* qp = QR + (size_t)row * 768 + h * DQK;
        const v4u qv = *(const v4u*)(qp + 8 * l8);
        float a1 = bf2f(qp[64 + l8]) * aq, a2 = bf2f(qp[72 + l8]) * aq, b1 = bf2f(qp[80 + l8]) * aq, b2 = bf2f(qp[88 + l8]) * aq;
        float ss = sumsq8(qv) * aq * aq + a1 * a1 + a2 * a2 + b1 * b1 + b2 * b2;
        ss += __shfl_xor(ss, 1); ss += __shfl_xor(ss, 2); ss += __shfl_xor(ss, 4);
        const float rq = __builtin_amdgcn_rsqf(ss * (1.0f / 96.0f) + EPS) * QSCALE; const float rqa = rq * aq;
        const f32x4 g0 = *(const f32x4*)(q_gain + 8 * l8), g1 = *(const f32x4*)(q_gain + 8 * l8 + 4);
        v4u o; o.x = pk2(bflo(qv.x) * rqa * g0[0], bfhi(qv.x) * rqa * g0[1]); o.y = pk2(bflo(qv.y) * rqa * g0[2], bfhi(qv.y) * rqa * g0[3]);
        o.z = pk2(bflo(qv.z) * rqa * g1[0], bfhi(qv.z) * rqa * g1[1]); o.w = pk2(bflo(qv.w) * rqa * g1[2], bfhi(qv.w) * rqa * g1[3]);
        a1 *= rq * q_gain[64 + l8]; a2 *= rq * q_gain[72 + l8]; b1 *= rq * q_gain[80 + l8]; b2 *= rq * q_gain[88 + l8];
        const float oa1 = a1 * cr - a2 * sr, oa2 = a2 * cr + a1 * sr, ob1 = b1 * cc - b2 * sc, ob2 = b2 * cc + b1 * sc;
        const unsigned w0 = pk2(oa1, oa2), w1 = pk2(ob1, ob2);
        *(v4u*)(qp + 8 * l8) = o;
        qp[64 + l8] = (bf16)(w0 & 0xffffu); qp[72 + l8] = (bf16)(w0 >> 16); qp[80 + l8] = (bf16)(w1 & 0xffffu); qp[88 + l8] = (bf16)(w1 >> 16);
    }
}
__device__ __forceinline__ void nyquist_item(Frame& F, int item) {
    const bf16* FT = (const bf16*)(F.ws + WS_FT); bf16* PM = (bf16*)(F.ws + WS_HX);
    const v4u* p = (const v4u*)(FT + (size_t)item * 4096) + F.lane; float s = 0.f;
#pragma unroll
    for (int i = 0; i < 8; ++i) { const v4u w = p[64 * i]; s += (bflo(w.x) - bfhi(w.x)) + (bflo(w.y) - bfhi(w.y)) + (bflo(w.z) - bfhi(w.z)) + (bflo(w.w) - bfhi(w.w)); }
    s = wave_sum(s);
    if (F.lane == 0) { const int b = item >> 9, col = item & 511; bf16* o = PM + ((size_t)(b * SEQ + 2048)) * 1024 + (col >> 7) * 256 + (col & 127);
        o[0] = (bf16)(pk2(s, 0.f) & 0xffffu); o[128] = 0; }
}

constexpr int AT_KROW = 208, AT_VROW = 144;
constexpr int AT_KT = 64 * AT_KROW, AT_VT = 64 * AT_VROW;
constexpr int AT_STAGE = 2 * AT_KT + 2 * AT_VT;
static_assert(2 * AT_STAGE <= RING_BYTES, "attention LDS");
__device__ __forceinline__ f32x16 mfma32(bf16x8 a, bf16x8 b, f32x16 c) { return __builtin_amdgcn_mfma_f32_32x32x16_bf16(a, b, c, 0, 0, 0); }

__device__ __forceinline__ void attn_unit(Frame& F, int bh, int qb) {
    const bf16* QR = (const bf16*)(F.ws + WS_QR); const bf16* KF = (const bf16*)(F.ws + WS_KF); const bf16* VT = (const bf16*)(F.ws + WS_VT); bf16* ATT = (bf16*)(F.ws + WS_ATT);
    const int tid = F.tid, lane = F.lane, wave = F.wave, qg = wave & 3, kh = wave >> 2, r = lane & 31, hh = lane >> 5;
    const int b = bh >> 3, h = bh & 7;
    const int tok = b * SEQ + qb * 128 + qg * 32 + r;
    bf16x8 qf[6];
    { const bf16* qp = QR + (size_t)tok * 768 + h * DQK + 8 * hh;
#pragma unroll
      for (int ks = 0; ks < 6; ++ks) qf[ks] = *(const bf16x8*)(qp + 16 * ks); }
    const unsigned char* kg = (const unsigned char*)(KF + (size_t)bh * NKEY * DQK);
    const unsigned char* vg = (const unsigned char*)(VT + (size_t)bh * DV * NKEY);
    int kso[3], kdo[3], vso[2], vdo[2];
#pragma unroll
    for (int i = 0; i < 3; ++i) { const int c = tid + 512 * i; const int key = c / 12, part = c % 12; kso[i] = c * 16; kdo[i] = (key >> 6) * AT_KT + (key & 63) * AT_KROW + part * 16; }
#pragma unroll
    for (int i = 0; i < 2; ++i) { const int c = tid + 512 * i; const int dv = c >> 4, part = c & 15; vso[i] = dv * (NKEY * 2) + part * 16; vdo[i] = 2 * AT_KT + (part >> 3) * AT_VT + dv * AT_VROW + (part & 7) * 16; }
    v4u sk[3], sv[2];
#define AT_LOAD(pair) do { _Pragma("unroll") for (int i = 0; i < 3; ++i) sk[i] = *(const v4u*)(kg + (size_t)(pair) * (128 * 192) + kso[i]); \
                           _Pragma("unroll") for (int i = 0; i < 2; ++i) sv[i] = *(const v4u*)(vg + (size_t)(pair) * 256 + vso[i]); } while (0)
#define AT_WRITE(st) do { LAS unsigned char* d_ = F.lds + RING_OFF + (st) * AT_STAGE; _Pragma("unroll") for (int i = 0; i < 3; ++i) *(LAS v4u*)(d_ + kdo[i]) = sk[i]; \
                          _Pragma("unroll") for (int i = 0; i < 2; ++i) *(LAS v4u*)(d_ + vdo[i]) = sv[i]; } while (0)
    AT_LOAD(0); AT_WRITE(0);
    __syncthreads();
    f32x16 o0, o1;
#pragma unroll
    for (int i = 0; i < 16; ++i) { o0[i] = 0.f; o1[i] = 0.f; }
    float mrun = -INFINITY, lrun = 0.f;
    const int pr = (r & 0x13) | ((r & 4) << 1) | ((r & 8) >> 1);
    const int koff = kh * AT_KT + pr * AT_KROW + 16 * hh, voff = 2 * AT_KT + kh * AT_VT + r * AT_VROW + 16 * hh;
    constexpr int NPAIR = NKEY / 128;
    for (int it = 0; it < NPAIR; ++it) {
        if (it + 1 < NPAIR) AT_LOAD(it + 1);
        const LAS unsigned char* st = F.lds + RING_OFF + (it & 1) * AT_STAGE;
        f32x16 s0, s1;
#pragma unroll
        for (int i = 0; i < 16; ++i) { s0[i] = 0.f; s1[i] = 0.f; }
#pragma unroll
        for (int ks = 0; ks < 6; ++ks) {
            const bf16x8 k0 = *(const LAS bf16x8*)(st + koff + ks * 32), k1 = *(const LAS bf16x8*)(st + koff + 32 * AT_KROW + ks * 32);
            s0 = mfma32(k0, qf[ks], s0); s1 = mfma32(k1, qf[ks], s1);
        }
        float mx = fmaxf(s0[0], s1[0]);
#pragma unroll
        for (int i = 1; i < 16; ++i) mx = fmaxf(mx, fmaxf(s0[i], s1[i]));
        mx = fmaxf(mx, __shfl_xor(mx, 32));
        const float mnew = fmaxf(mrun, mx), alpha = __builtin_amdgcn_exp2f(mrun - mnew);
        mrun = mnew;
        float ps = 0.f;
#pragma unroll
        for (int i = 0; i < 16; ++i) { s0[i] = __builtin_amdgcn_exp2f(s0[i] - mnew); s1[i] = __builtin_amdgcn_exp2f(s1[i] - mnew); ps += s0[i] + s1[i]; }
        lrun = lrun * alpha + ps;
#pragma unroll
        for (int i = 0; i < 16; ++i) { o0[i] *= alpha; o1[i] *= alpha; }
        bf16x8 p00, p01, p10, p11;
        { v4u w; w.x = pk2(s0[0], s0[1]); w.y = pk2(s0[2], s0[3]); w.z = pk2(s0[4], s0[5]); w.w = pk2(s0[6], s0[7]); p00 = __builtin_bit_cast(bf16x8, w);
          w.x = pk2(s0[8], s0[9]); w.y = pk2(s0[10], s0[11]); w.z = pk2(s0[12], s0[13]); w.w = pk2(s0[14], s0[15]); p01 = __builtin_bit_cast(bf16x8, w);
          w.x = pk2(s1[0], s1[1]); w.y = pk2(s1[2], s1[3]); w.z = pk2(s1[4], s1[5]); w.w = pk2(s1[6], s1[7]); p10 = __builtin_bit_cast(bf16x8, w);
          w.x = pk2(s1[8], s1[9]); w.y = pk2(s1[10], s1[11]); w.z = pk2(s1[12], s1[13]); w.w = pk2(s1[14], s1[15]); p11 = __builtin_bit_cast(bf16x8, w); }
        { const LAS unsigned char* vb = st + voff;
          o0 = mfma32(*(const LAS bf16x8*)(vb + 0),  p00, o0); o1 = mfma32(*(const LAS bf16x8*)(vb + 32 * AT_VROW + 0),  p00, o1);
          o0 = mfma32(*(const LAS bf16x8*)(vb + 32), p01, o0); o1 = mfma32(*(const LAS bf16x8*)(vb + 32 * AT_VROW + 32), p01, o1);
          o0 = mfma32(*(const LAS bf16x8*)(vb + 64), p10, o0); o1 = mfma32(*(const LAS bf16x8*)(vb + 32 * AT_VROW + 64), p10, o1);
          o0 = mfma32(*(const LAS bf16x8*)(vb + 96), p11, o0); o1 = mfma32(*(const LAS bf16x8*)(vb + 32 * AT_VROW + 96), p11, o1); }
        if (it + 1 < NPAIR) AT_WRITE((it + 1) & 1);
        __syncthreads();
    }
#undef AT_LOAD
#undef AT_WRITE
    lrun += __shfl_xor(lrun, 32);
    LAS float* mg = (LAS float*)(F.lds + RING_OFF) + (qg * 64 + lane);
    if (kh == 1) {
        mg[0] = mrun; mg[256] = lrun;
#pragma unroll
        for (int i = 0; i < 16; ++i) { mg[(2 + i) * 256] = o0[i]; mg[(18 + i) * 256] = o1[i]; }
    }
    __syncthreads();
    if (kh == 0) {
        const float m1 = mg[0], l1 = mg[256];
        const float m = fmaxf(mrun, m1), a0 = __builtin_amdgcn_exp2f(mrun - m), a1 = __builtin_amdgcn_exp2f(m1 - m);
        const float inv = 1.0f / (lrun * a0 + l1 * a1); const float c0 = a0 * inv, c1 = a1 * inv;
        bf16* op = ATT + (size_t)tok * 512 + h * DV + 4 * hh;
#pragma unroll
        for (int g = 0; g < 4; ++g) {
            float x0[4], x1[4];
#pragma unroll
            for (int e = 0; e < 4; ++e) { x0[e] = o0[4 * g + e] * c0 + mg[(2 + 4 * g + e) * 256] * c1; x1[e] = o1[4 * g + e] * c0 + mg[(18 + 4 * g + e) * 256] * c1; }
            v2u w; w.x = pk2(x0[0], x0[1]); w.y = pk2(x0[2], x0[3]); *(v2u*)(op + 8 * g) = w;
            w.x = pk2(x1[0], x1[1]); w.y = pk2(x1[2], x1[3]); *(v2u*)(op + 32 + 8 * g) = w;
        }
    }
}
__device__ __forceinline__ void attn_phase(Frame& F) {
    const unsigned x0 = xb_xcc_id() & 7u;
    for (;;) {
        __syncthreads();
        if (F.tid == 0) { int unit = -1;
            for (unsigned d = 0; d < 8; ++d) { const unsigned x = (x0 + d) & 7u; gu32* hq = F.ctl + CW_ATTQ + 64 * x;
                if (__hip_atomic_load(hq, RLX_AGENT) >= 128u) continue;
                const unsigned j = __hip_atomic_fetch_add(hq, 1u, RLX_AGENT);
                if (j < 128u) { unit = (int)(x * 128u + j); break; } }
            F.MISC[16] = (unsigned)unit; }
        __syncthreads();
        const int unit = (int)F.MISC[16];
        if (unit < 0) break;
        const int x = unit >> 7, j = unit & 127;
        attn_unit(F, x + 8 * (j >> 5), j & 31);
    }
}

#define AS4 __attribute__((address_space(4)))
#define PHASE_FRAME() Frame F; { int t_ = threadIdx.x; asm volatile("" : "+v"(t_)); F.tid = t_; F.lane = t_ & 63; F.wave = __builtin_amdgcn_readfirstlane(t_ >> 6); \
    int bx_ = blockIdx.x, g_ = gridDim.x; asm volatile("" : "+s"(bx_), "+s"(g_)); F.G = g_; F.bx = bx_; F.vcu = (g_ % 8 == 0) ? (bx_ % 8) * (g_ / 8) + bx_ / 8 : bx_; \
    const AS4 Args* ap_ = (const AS4 Args*)__builtin_amdgcn_kernarg_segment_ptr(); asm volatile("" : "+s"(ap_)); F.ap = ap_; F.ws = ap_->ws; F.ctl = (gu32*)(F.ws + WS_CTL); \
    F.lds = (LAS unsigned char*)lds; F.MISC = (volatile LAS unsigned*)(F.lds + MISC_OFF); } \
    unsigned char* const ws = F.ws; const float* const MOD = (const float*)(ws + WS_MOD); bf16* const HX = (bf16*)(ws + WS_HX); (void)MOD; (void)HX
#define ARG(i) (F.ap->in[i])
__global__ void __launch_bounds__(512, 2) mk_fwd(Args args_unused) {
    extern __shared__ __attribute__((aligned(16))) unsigned char lds[];
    int lo, hi;
    XcdBarrier bar;
    {
        PHASE_FRAME();
        for (int u = F.tid; u < 512 / 4; u += 512) ((LAS unsigned*)(F.lds + LDSCTL_OFF))[u] = 0u;
        __syncthreads();
        bar.bar = (unsigned*)(F.ctl + CW_BAR); bar.x = 0; bar.st = nullptr;
        if (N_LAUNCHES == 1) bar = xcd_barrier_post((unsigned*)(F.ctl + CW_BAR), F.MISC + 8);
        lo = F.ap->ph_lo; hi = F.ap->ph_hi;
    }
#define IN(k) (lo <= (k) && (k) < hi)
#define SEAM(k) do { if (IN(k) && IN((k) + 1)) xcd_barrier(bar); } while (0)

    if (IN(0)) { PHASE_FRAME(); p0_prep(F); } SEAM(0);
    if (IN(1)) { PHASE_FRAME(); p1_mod(F); } SEAM(1);
    if (IN(2)) { PHASE_FRAME();
        if (F.bx < 4) {
            const int r0 = F.bx * 256 + F.wave * 32;
            for (int i = 0; i < 32; ++i) { const int cr = r0 + i; norm_mod_row(ARG(2) + (size_t)cr * 1024, ARG(6), MOD + 4 * 6144, MOD + 4 * 6144 + 1024, HX + (size_t)(MT + cr) * 1024, F.lane); }
            VM_WAIT(); __syncthreads();
            pg8::Gemm g{HX, (const bf16*)(ws + WS_WIN), MA, DINP, 1024}; OneUnit S{64 + (int)F.bx, 3};
            EpiInProj E{(bf16*)(ws + WS_FT), (bf16*)(ws + WS_QL), (bf16*)(ws + WS_KVK), (bf16*)(ws + WS_GATES), ARG(9)};
            pg8::gemm_phase<EpiInProj, OneUnit, true, true>(F.lds + RING_OFF, g, S, E);
        } else {
            const int gw = ((int)F.bx - 4) * 8 + F.wave, NGW = (F.G - 4) * 8;
            for (int row = gw; row < MT; row += NGW) { const int b = row >> 12; norm_mod_row(ARG(0) + (size_t)row * 1024, ARG(6), MOD + b * 6144, MOD + b * 6144 + 1024, HX + (size_t)row * 1024, F.lane); }
        }
    } SEAM(2);
    if (IN(3)) { PHASE_FRAME();
        pg8::Gemm g{HX, (const bf16*)(ws + WS_WIN), MT, DINP, 1024}; pg8::StaticOrder S; S.init(MT, DINP, F.G, (int)F.bx);
        EpiInProj E{(bf16*)(ws + WS_FT), (bf16*)(ws + WS_QL), (bf16*)(ws + WS_KVK), (bf16*)(ws + WS_GATES), ARG(9)};
        pg8::gemm_phase<EpiInProj, pg8::StaticOrder, true, true>(F.lds + RING_OFF, g, S, E);
    } SEAM(3);
    if (IN(4)) { PHASE_FRAME();
        { pg8::Gemm g{(const bf16*)(ws + WS_KVK), (const bf16*)(ws + WS_WKVB), MA, 1024, 256}; pg8::StaticOrder S; S.init(MA, 1024, F.G, (int)F.bx);
          EpiKvUp E{(const bf16*)(ws + WS_KVK), (bf16*)(ws + WS_KF), (bf16*)(ws + WS_VT)};
          pg8::gemm_phase<EpiKvUp, pg8::StaticOrder, true, true>(F.lds + RING_OFF, g, S, E); }
        { pg8::Gemm g{(const bf16*)(ws + WS_QL), (const bf16*)(ws + WS_WQB), MT, 768, 256}; pg8::StaticOrder S; S.init(MT, 768, F.G, (int)(((unsigned)F.bx + 192u) % (unsigned)F.G));
          EpiStore<0> E{(bf16*)(ws + WS_QR), 768};
          pg8::gemm_phase<EpiStore<0>, pg8::StaticOrder, true, true>(F.lds + RING_OFF, g, S, E); }
    } SEAM(4);
    if (IN(5)) { PHASE_FRAME();
        const int gw = F.vcu * 8 + F.wave, NGW = F.G * 8;
        for (int row = gw; row < MA; row += NGW) finalize_row(F, row);
        for (int it = gw; it < NB * 512; it += NGW) nyquist_item(F, it);
    } SEAM(5);
    if (IN(6)) { PHASE_FRAME();
        if (F.bx < 128) { const int uid = F.bx; const int b = uid >> 5;
            pg8::Gemm g{(const bf16*)(ws + WS_DFT), (const bf16*)(ws + WS_FT) + (size_t)b * 512 * 4096, 4096, 512, 4096}; OneUnit S{(uid >> 1) & 15, uid & 1};
            EpiDft E{HX, b};
            pg8::gemm_phase<EpiDft, OneUnit, true, true>(F.lds + RING_OFF, g, S, E); }
        attn_phase(F);
    } SEAM(6);
    if (IN(7)) { PHASE_FRAME();
        { pg8::Gemm g{HX, (const bf16*)(ws + WS_WF), MT, 1024, 1024}; pg8::StaticOrder S; S.init(MT, 1024, F.G, (int)F.bx);
          EpiMerge1 E{(const bf16*)(ws + WS_GATES), (bf16*)(ws + WS_Y)};
          pg8::gemm_phase<EpiMerge1, pg8::StaticOrder, true, true>(F.lds + RING_OFF, g, S, E); }
        { pg8::Gemm g{(const bf16*)(ws + WS_ATT), (const bf16*)(ws + WS_WMO), MT, 1024, 512}; pg8::StaticOrder S; S.init(MT, 1024, F.G, (int)F.bx);
          EpiMerge2 E{(const bf16*)(ws + WS_GATES), (bf16*)(ws + WS_Y)};
          pg8::gemm_phase<EpiMerge2, pg8::StaticOrder, true, true>(F.lds + RING_OFF, g, S, E); }
    } SEAM(7);
    if (IN(8)) { PHASE_FRAME();
        pg8::Gemm g{(const bf16*)(ws + WS_Y), (const bf16*)(ws + WS_WOUT), MT, 1024, 1024}; pg8::StaticOrder S; S.init(MT, 1024, F.G, (int)F.bx);
        EpiResid E{ARG(0), F.ap->out, MOD + 2048};
        pg8::gemm_phase<EpiResid, pg8::StaticOrder, true, true>(F.lds + RING_OFF, g, S, E);
    } SEAM(8);
    if (IN(9)) { PHASE_FRAME();
        const int gw = F.vcu * 8 + F.wave, NGW = F.G * 8;
        for (int row = gw; row < MT; row += NGW) { const int b = row >> 12; norm_mod_row(F.ap->out + (size_t)row * 1024, ARG(7), MOD + b * 6144 + 3072, MOD + b * 6144 + 4096, HX + (size_t)row * 1024, F.lane); }
        p9_weights(F);
    } SEAM(9);
    if (IN(10)) { PHASE_FRAME();
        pg8::Gemm g{HX, (const bf16*)(ws + WS_WUP), MT, DFF, 1024}; pg8::StaticOrder S; S.init(MT, DFF, F.G, (int)F.bx);
        EpiStore<1> E{(bf16*)(ws + WS_U), DFF};
        pg8::gemm_phase<EpiStore<1>, pg8::StaticOrder, true, true>(F.lds + RING_OFF, g, S, E);
    } SEAM(10);
    if (IN(11)) { PHASE_FRAME();
        pg8::Gemm g{(const bf16*)(ws + WS_U), (const bf16*)(ws + WS_WDOWN), MT, 1024, DFF}; pg8::StaticOrder S; S.init(MT, 1024, F.G, (int)F.bx);
        EpiResid E{F.ap->out, F.ap->out, MOD + 5120};
        pg8::gemm_phase<EpiResid, pg8::StaticOrder, true, true>(F.lds + RING_OFF, g, S, E);
    }
#ifdef DBG_DUMP_OFF
    {
        xcd_barrier(bar);
        PHASE_FRAME();
        const bf16* src = (const bf16*)(ws + (size_t)DBG_DUMP_OFF); float* o = F.ap->out;
        for (size_t i = (size_t)F.vcu * 512 + F.tid; i < (size_t)MT * 1024; i += (size_t)F.G * 512) o[i] = bf2f(src[i]);
    }
#endif
#undef IN
#undef SEAM
}

#ifndef DBG_LO
#define DBG_LO 0
#endif
#ifndef DBG_HI
#define DBG_HI N_PHASES
#endif
extern "C" void kernel_launch(void* const* d_in, const int* in_sizes, int n_in, void* d_out, int out_size, void* d_ws, size_t ws_size, hipStream_t stream) {
    static int grid = 0;
    if (grid == 0) {
        if (n_in != 21 || in_sizes[0] != MT * DM || out_size != MT * DM || ws_size < WS_END) { fprintf(stderr, "kernel_launch: unexpected shapes (n_in %d, in0 %d, out %d, ws %zu)\n", n_in, n_in > 0 ? in_sizes[0] : -1, out_size, ws_size); grid = -1; return; }
        int dev = 0, cus = 0, per_cu = 0;
        if (hipGetDevice(&dev) != hipSuccess || hipDeviceGetAttribute(&cus, hipDeviceAttributeMultiprocessorCount, dev) != hipSuccess) { grid = -1; return; }
        if (hipFuncSetAttribute((const void*)mk_fwd, hipFuncAttributeMaxDynamicSharedMemorySize, LDS_BYTES) != hipSuccess) { fprintf(stderr, "kernel_launch: hipFuncSetAttribute failed\n"); grid = -1; return; }
        if (hipOccupancyMaxActiveBlocksPerMultiprocessor(&per_cu, (const void*)mk_fwd, 512, LDS_BYTES) != hipSuccess || per_cu < 1) fprintf(stderr, "kernel_launch: occupancy query reports %d per CU\n", per_cu);
        (void)hipGetLastError();
        grid = cus;
        if (grid < 128) { fprintf(stderr, "kernel_launch: needs >= 128 CUs\n"); grid = -1; return; }
    }
    if (grid < 0) return;
    if (hipMemsetAsync((char*)d_ws + WS_CTL, 0, CTL_ZERO_BYTES, stream) != hipSuccess) return;
    Args a{};
    for (int i = 0; i < 21; ++i) a.in[i] = (const float*)d_in[i];
    a.out = (float*)d_out; a.ws = (unsigned char*)d_ws;
    for (int li = 0; li < N_LAUNCHES; ++li) {
        a.ph_lo = (N_LAUNCHES == 1) ? DBG_LO : li; a.ph_hi = (N_LAUNCHES == 1) ? DBG_HI : li + 1; a.li = li;
        hipLaunchKernelGGL(mk_fwd, dim3(grid), dim3(512), LDS_BYTES, stream, a);
        const hipError_t le = hipPeekAtLastError();
        if (le != hipSuccess) { fprintf(stderr, "kernel_launch: launch %d failed: %s\n", li, hipGetErrorName(le)); break; }
    }
}
```

```cpp
#include <hip/hip_runtime.h>
#include <cstdio>
#include <cstdint>
namespace pg8 {
#define PG8_LAS __attribute__((address_space(3)))
typedef unsigned short bf16_t;
typedef short bf16x8 __attribute__((ext_vector_type(8)));
typedef float f32x4 __attribute__((ext_vector_type(4)));
typedef unsigned u32x4 __attribute__((ext_vector_type(4)));
constexpr int BM = 256, BK = 64, HALF = 128, HTB = HALF * BK * 2  , STAGE_BYTES = 8 * HTB, NXCD = 8, WGM = 8;

__host__ __device__ __forceinline__ int lds_byte(int r, int c) { const int st = (r >> 4) * 2 + (c >> 5), rr = r & 15, cc = c & 31, ob = rr * 64 + cc * 2; return st * 1024 + (ob ^ (((ob >> 9) & 1) << 5)); }
__host__ __device__ __forceinline__ void stage_rc(int b, int& R, int& C) { const int st = b / 1024, sb = b % 1024, swz = sb ^ (((sb >> 9) & 1) << 5); R = (st >> 1) * 16 + swz / 64; C = (st & 1) * 32 + (swz % 64) / 2; }
__host__ __device__ __forceinline__ int perm32(int rho) { const int n = rho >> 4, i = rho & 15; return 8 * (i >> 2) + 4 * n + (i & 3); }

struct Unit { int pm, pn; };
struct Gemm { const bf16_t* A; const bf16_t* Bt; int M, N, K; };

struct StaticOrder {
    int nM, nN, nwg, G, c;
    __host__ __device__ void init(int M, int N, int G_, int c_) { nM = M / BM; nN = N / BM; nwg = nM * nN; G = G_; c = c_; }
    __host__ __device__ bool next(int i, Unit& u) const {
        const long L = (long)i * G + c; if (L >= nwg) return false;
        int wgid = (int)L; { const int q = nwg / NXCD, r = nwg % NXCD, xcd = wgid % NXCD, off = wgid / NXCD; wgid = (xcd < r ? xcd * (q + 1) : r * (q + 1) + (xcd - r) * q) + off; }
        const int nig = WGM * nN, gid = wgid / nig, fm = gid * WGM, gsz = (nM - fm) < WGM ? (nM - fm) : WGM;
        u.pm = fm + ((wgid % nig) % gsz); u.pn = (wgid % nig) / gsz; return true;
    }
    __device__ __forceinline__ void a_ready(const Unit&) const {}
    __device__ __forceinline__ void done(const Unit&) const {}
};

__device__ __forceinline__ unsigned cvt_pk_bf16(float lo, float hi) { unsigned r; asm volatile("v_cvt_pk_bf16_f32 %0, %1, %2" : "=v"(r) : "v"(lo), "v"(hi)); return r; }
template <class Epi, class Sched, bool ALIGN_EPI = false, bool SP2 = false>
__device__ __forceinline__ void gemm_phase(PG8_LAS unsigned char* lds, const Gemm g, const Sched& S, const Epi& E) {
    int tid_ = threadIdx.x; asm volatile("" : "+v"(tid_)); const int tid = tid_, wid = __builtin_amdgcn_readfirstlane(tid >> 6), lane = tid & 63, wr = wid >> 2, wc = wid & 3, fr = lane & 15, fq = lane >> 4;
    const int K = g.K, nt = K / BK;
    unsigned voffA[2], voffB[2];
#pragma unroll
    for (int i = 0; i < 2; ++i) { int R, C; stage_rc(tid * 16 + i * 8192, R, C); const int Rb = Epi::PERM ? ((R & ~31) + perm32(R & 31)) : R;
        voffA[i] = (unsigned)(R * K + C) * 2u; voffB[i] = (unsigned)(Rb * K + C) * 2u; }
    const size_t kstep = (size_t)(BK * 2);
    const size_t hstep = (size_t)HALF * K * 2;
    const size_t tstep = 2 * hstep;
    const unsigned ldsw = (unsigned)wid * 1024u;
    const int aoff = lds_byte(wr * 64 + fr, fq * 8), boff = lds_byte(wc * 32 + fr, fq * 8);
#define PG8_SA(b, h) (((b) * 2 + (h)) * HTB)
#define PG8_SB(b, h) ((4 + (b) * 2 + (h)) * HTB)
#define PG8_STAGE(bufoff, gbase, voff) do { _Pragma("unroll") for (int _i = 0; _i < 2; ++_i) \
        __builtin_amdgcn_global_load_lds((const unsigned*)((const char*)(gbase) + (voff)[_i]), (PG8_LAS unsigned*)(lds + (bufoff) + ldsw + _i * 8192), 16, 0, 0); } while (0)
#define PG8_LDA(dst, b, h) do { _Pragma("unroll") for (int m = 0; m < 4; ++m) _Pragma("unroll") for (int k = 0; k < 2; ++k) dst[m][k] = *(const PG8_LAS bf16x8*)(lds + PG8_SA(b, h) + aoff + m * 2048 + k * 1024); } while (0)
#define PG8_LDB(dst, b, h) do { _Pragma("unroll") for (int n = 0; n < 2; ++n) _Pragma("unroll") for (int k = 0; k < 2; ++k) dst[n][k] = *(const PG8_LAS bf16x8*)(lds + PG8_SB(b, h) + boff + n * 2048 + k * 1024); } while (0)
#define PG8_MMA(ai, bj, At, Bt) do { __builtin_amdgcn_s_setprio(1); _Pragma("unroll") for (int m = 0; m < 4; ++m) _Pragma("unroll") for (int n = 0; n < 2; ++n) _Pragma("unroll") for (int k = 0; k < 2; ++k) \
        acc[ai][bj][m][n] = __builtin_amdgcn_mfma_f32_16x16x32_bf16(Bt[n][k], At[m][k], acc[ai][bj][m][n], 0, 0, 0); __builtin_amdgcn_s_setprio(0); } while (0)
#define PG8_WAIT_V(n) asm volatile("s_waitcnt vmcnt(" #n ")" ::: "memory")
#define PG8_WAIT_L(n) asm volatile("s_waitcnt lgkmcnt(" #n ")" ::: "memory")
#define PG8_BAR __builtin_amdgcn_s_barrier()
#define PG8_SCHED __builtin_amdgcn_sched_barrier(0)
    Unit cur, nxt; int ui = 0;
    if (!S.next(0, cur)) return;
    f32x4 acc[2][2][4][2];
#pragma unroll
    for (int a = 0; a < 2; ++a)
#pragma unroll
        for (int b = 0; b < 2; ++b)
#pragma unroll
            for (int m = 0; m < 4; ++m)
#pragma unroll
                for (int n = 0; n < 2; ++n) acc[a][b][m][n] = (f32x4){0.f, 0.f, 0.f, 0.f};
    bf16x8 At[4][2], B0[2][2], B1[2][2];
    const char* cA = (const char*)g.A + (size_t)cur.pm * tstep; const char* cB = (const char*)g.Bt + (size_t)cur.pn * tstep;
    S.a_ready(cur);
    if constexpr (SP2) {
        PG8_STAGE(PG8_SB(0, 0), cB, voffB); PG8_STAGE(PG8_SB(0, 1), cB + hstep, voffB); PG8_STAGE(PG8_SA(0, 0), cA, voffA); PG8_STAGE(PG8_SA(0, 1), cA + hstep, voffA);
        if (wr == 1) PG8_BAR;
        PG8_WAIT_V(2); PG8_BAR;
        PG8_STAGE(PG8_SB(1, 0), cB + kstep, voffB); PG8_STAGE(PG8_SA(1, 0), cA + kstep, voffA); PG8_STAGE(PG8_SB(1, 1), cB + hstep + kstep, voffB);
        PG8_WAIT_V(6); PG8_BAR;
    } else {
        PG8_STAGE(PG8_SB(0, 0), cB, voffB); PG8_STAGE(PG8_SA(0, 0), cA, voffA); PG8_STAGE(PG8_SB(0, 1), cB + hstep, voffB); PG8_STAGE(PG8_SA(0, 1), cA + hstep, voffA);
        if (wr == 1) PG8_BAR;
        PG8_WAIT_V(4); PG8_BAR;
        PG8_STAGE(PG8_SB(1, 0), cB + kstep, voffB); PG8_STAGE(PG8_SA(1, 0), cA + kstep, voffA); PG8_STAGE(PG8_SB(1, 1), cB + hstep + kstep, voffB);
        PG8_WAIT_V(6); PG8_BAR;
    }
    for (;;) {
        const bool has_next = S.next(ui + 1, nxt);
        const char* nA = has_next ? (const char*)g.A + (size_t)nxt.pm * tstep : cA; const char* nB = has_next ? (const char*)g.Bt + (size_t)nxt.pn * tstep : cB;
        for (int t = 0; t < nt; t += 2) {
            const bool last = (t == nt - 2);
            const char* a1 = cA + (size_t)(t + 1) * kstep;
            const char* a2 = last ? nA : cA + (size_t)(t + 2) * kstep; const char* b2 = last ? nB : cB + (size_t)(t + 2) * kstep;
            const char* a3 = a2 + kstep; const char* b3 = b2 + kstep;
            if (last && has_next) S.a_ready(nxt);
            if constexpr (SP2) {
            PG8_LDB(B0, 0, 0); PG8_LDB(B1, 0, 1); PG8_SCHED; PG8_LDA(At, 0, 0); PG8_STAGE(PG8_SA(1, 1), a1 + hstep, voffA);
            PG8_WAIT_V(8); PG8_WAIT_L(0); PG8_BAR; PG8_MMA(0, 0, At, B0); PG8_MMA(0, 1, At, B1); PG8_BAR; PG8_SCHED;
            PG8_LDA(At, 0, 1); PG8_STAGE(PG8_SB(0, 0), b2, voffB); PG8_STAGE(PG8_SB(0, 1), b2 + hstep, voffB); PG8_STAGE(PG8_SA(0, 0), a2, voffA);
            PG8_WAIT_V(8); PG8_WAIT_L(0); PG8_BAR; PG8_MMA(1, 0, At, B0); PG8_MMA(1, 1, At, B1); PG8_BAR; PG8_SCHED;
            PG8_LDB(B0, 1, 0); PG8_LDB(B1, 1, 1); PG8_SCHED; PG8_LDA(At, 1, 0); PG8_STAGE(PG8_SA(0, 1), a2 + hstep, voffA);
            PG8_WAIT_V(8); PG8_WAIT_L(0); PG8_BAR; PG8_MMA(0, 0, At, B0); PG8_MMA(0, 1, At, B1); PG8_BAR; PG8_SCHED;
            PG8_LDA(At, 1, 1); PG8_STAGE(PG8_SB(1, 0), b3, voffB); PG8_STAGE(PG8_SB(1, 1), b3 + hstep, voffB); PG8_STAGE(PG8_SA(1, 0), a3, voffA);
            PG8_WAIT_V(8); PG8_WAIT_L(0); PG8_BAR; PG8_MMA(1, 0, At, B0); PG8_MMA(1, 1, At, B1); PG8_BAR; PG8_SCHED;
            } else {
            PG8_LDB(B0, 0, 0); PG8_SCHED; PG8_LDA(At, 0, 0); PG8_STAGE(PG8_SA(1, 1), a1 + hstep, voffA);
            PG8_WAIT_L(8); PG8_BAR; PG8_WAIT_L(0); PG8_MMA(0, 0, At, B0); PG8_BAR; PG8_SCHED;
            PG8_LDB(B1, 0, 1); PG8_STAGE(PG8_SB(0, 0), b2, voffB);
            PG8_BAR; PG8_WAIT_L(0); PG8_MMA(0, 1, At, B1); PG8_BAR;
            PG8_LDA(At, 0, 1); PG8_STAGE(PG8_SA(0, 0), a2, voffA);
            PG8_BAR; PG8_WAIT_L(0); PG8_MMA(1, 0, At, B0); PG8_BAR; PG8_SCHED;
            PG8_STAGE(PG8_SB(0, 1), b2 + hstep, voffB);
            PG8_WAIT_V(6); PG8_BAR; PG8_MMA(1, 1, At, B1); PG8_BAR;
            PG8_LDB(B0, 1, 0); PG8_SCHED; PG8_LDA(At, 1, 0); PG8_STAGE(PG8_SA(0, 1), a2 + hstep, voffA);
            PG8_WAIT_L(8); PG8_BAR; PG8_WAIT_L(0); PG8_MMA(0, 0, At, B0); PG8_BAR; PG8_SCHED;
            PG8_LDB(B1, 1, 1); PG8_STAGE(PG8_SB(1, 0), b3, voffB);
            PG8_BAR; PG8_WAIT_L(0); PG8_MMA(0, 1, At, B1); PG8_BAR;
            PG8_LDA(At, 1, 1); PG8_STAGE(PG8_SA(1, 0), a3, voffA);
            PG8_BAR; PG8_WAIT_L(0); PG8_MMA(1, 0, At, B0); PG8_BAR; PG8_SCHED;
            PG8_STAGE(PG8_SB(1, 1), b3 + hstep, voffB);
            PG8_WAIT_V(6); PG8_BAR; PG8_MMA(1, 1, At, B1); PG8_BAR;
            }
        }
        if constexpr (ALIGN_EPI) { if (wr == 0) PG8_BAR; }
        if constexpr (!Epi::AFTER_DRAIN) { E(acc, cur, wr, wc, fr, fq); S.done(cur); }
        if (!has_next) break;
#pragma unroll
        for (int a = 0; a < 2; ++a)
#pragma unroll
            for (int b = 0; b < 2; ++b)
#pragma unroll
                for (int m = 0; m < 4; ++m)
#pragma unroll
                    for (int n = 0; n < 2; ++n) acc[a][b][m][n] = (f32x4){0.f, 0.f, 0.f, 0.f};
        cur = nxt; cA = nA; cB = nB; ++ui;
        if constexpr (ALIGN_EPI) { if (wr == 1) PG8_BAR; }
    }
    PG8_WAIT_V(0);
    if constexpr (!ALIGN_EPI) { if (wr == 0) PG8_BAR; }
    PG8_BAR;
    if constexpr (Epi::AFTER_DRAIN) { E.fused(acc, cur, wr, wc, fr, fq, lds, wid, lane); S.done(cur); }
#undef PG8_SA
#undef PG8_SB
#undef PG8_STAGE
#undef PG8_LDA
#undef PG8_LDB
#undef PG8_MMA
#undef PG8_WAIT_V
#undef PG8_WAIT_L
#undef PG8_BAR
#undef PG8_SCHED
}
}

#define GAS __attribute__((address_space(1)))
#define LAS __attribute__((address_space(3)))
typedef unsigned short bf16;
typedef unsigned v4u __attribute__((ext_vector_type(4)));
typedef unsigned v2u __attribute__((ext_vector_type(2)));
typedef float f32x4 __attribute__((ext_vector_type(4)));
typedef float f32x16 __attribute__((ext_vector_type(16)));
typedef short bf16x8 __attribute__((ext_vector_type(8)));
typedef GAS unsigned gu32;
#define RLX_AGENT __ATOMIC_RELAXED, __HIP_MEMORY_SCOPE_AGENT
#define LDS_WAIT() asm volatile("s_waitcnt lgkmcnt(0)" ::: "memory")
#define VM_WAIT() asm volatile("s_waitcnt vmcnt(0)" ::: "memory")

#ifndef MK_N_LAUNCHES
#define MK_N_LAUNCHES 1
#endif
constexpr int N_PHASES = 12;
constexpr int N_LAUNCHES = MK_N_LAUNCHES;
#define XB_TMO      128
#define XB_XCNT(j)  (256  + 64 * (j))
#define XB_XSUB(j)  (1280 + 64 * (j))
#define XB_XGEN(j)  (2304 + 64 * (j))
#define XB_TOP      3328
#define XB_TOPGEN   3392
#define XCD_BAR_WORDS 3456
#define XB_SPIN_CAP (1u << 18)

__device__ __forceinline__ unsigned xb_ld(unsigned* p)              { return __hip_atomic_load(p, __ATOMIC_RELAXED, __HIP_MEMORY_SCOPE_AGENT); }
__device__ __forceinline__ unsigned xb_add(unsigned* p, unsigned v) { return __hip_atomic_fetch_add(p, v, __ATOMIC_RELAXED, __HIP_MEMORY_SCOPE_AGENT); }
__device__ __forceinline__ unsigned xb_xcc_id() { return (unsigned)__builtin_amdgcn_s_getreg((3 << 11) | 20) & 0xFu; }
#define XB_SPIN(cond, bar) do { unsigned _sp = 0; while (cond) { __builtin_amdgcn_s_sleep(1); \
    if ((++_sp & 255u) == 0u) { if (xb_ld(&(bar)[XB_TMO])) break; if (_sp > XB_SPIN_CAP) { atomicAdd(&(bar)[XB_TMO], 1u); break; } } } } while (0)

struct XcdBarrier {
    unsigned* bar; unsigned x;
    volatile LAS unsigned* st;
};

__device__ __forceinline__ XcdBarrier xcd_barrier_post(unsigned* bar, volatile LAS unsigned* st) {
    XcdBarrier b; b.bar = bar; b.x = xb_xcc_id(); b.st = st;
    if (threadIdx.x == 0) (void)xb_add(&bar[XB_XCNT(b.x)], 1u);
    return b;
}
__device__ __forceinline__ void xcd_barrier_complete(unsigned* bar, unsigned x, unsigned& nloc, unsigned& nx) {
    const unsigned G = gridDim.x * gridDim.y * gridDim.z;
    unsigned sum, cnt, mine, sp = 0u;
    for (;;) {
        sum = 0u; cnt = 0u; mine = 0u;
#pragma unroll
        for (unsigned j = 0; j < 16; ++j) { const unsigned c = xb_ld(&bar[XB_XCNT(j)]); sum += c; cnt += (c > 0u) ? 1u : 0u; mine = (j == x) ? c : mine; }
        if (sum == G) break;
        __builtin_amdgcn_s_sleep(1);
        if ((++sp & 255u) == 0u) { if (xb_ld(&bar[XB_TMO])) break; if (sp > XB_SPIN_CAP) { atomicAdd(&bar[XB_TMO], 1u); break; } }
    }
    nloc = mine > 0u ? mine : 1u; nx = cnt > 0u ? cnt : 1u;
}

__device__ __forceinline__ void xcd_barrier(const XcdBarrier& b) {
    asm volatile("s_waitcnt vmcnt(0)" ::: "memory");
    __syncthreads();
    if (threadIdx.x == 0) {
        unsigned* bar = b.bar;
        __builtin_amdgcn_s_waitcnt(0);
        unsigned nloc = b.st[0], nx = b.st[1];
        if (nloc == 0u) { xcd_barrier_complete(bar, b.x, nloc, nx); b.st[0] = nloc; b.st[1] = nx; }
        const unsigned old = xb_add(&bar[XB_XSUB(b.x)], 1u);
        const unsigned gen = old / nloc;
        if (old + 1u == (gen + 1u) * nloc) {
            __builtin_amdgcn_fence(__ATOMIC_RELEASE, "agent");
            asm volatile("s_waitcnt vmcnt(0)" ::: "memory");
            const unsigned og = xb_add(&bar[XB_TOP], 1u);
            const unsigned tg = og / nx;
            if (og + 1u == (tg + 1u) * nx) xb_add(&bar[XB_TOPGEN], 1u);
            else XB_SPIN(xb_ld(&bar[XB_TOPGEN]) == tg, bar);
            __builtin_amdgcn_fence(__ATOMIC_ACQUIRE, "agent");
            xb_add(&bar[XB_XGEN(b.x)], 1u);
            asm volatile("s_waitcnt vmcnt(0)" ::: "memory");
        } else {
            XB_SPIN(xb_ld(&bar[XB_XGEN(b.x)]) == gen, bar);
            __builtin_amdgcn_fence(__ATOMIC_ACQUIRE, "agent");
            asm volatile("s_waitcnt vmcnt(0)" ::: "memory");
        }
    }
    __syncthreads();
}

constexpr int NB = 4, SEQ = 4096, DM = 1024, MT = NB * SEQ, CTXL = 256, CT = NB * CTXL, MA = MT + CT;
constexpr int NH = 8, DQK = 96, DV = 64, NKEY = SEQ + CTXL;
constexpr int DIN = 2976, DINP = 3072, DFF = 4096;
constexpr float EPS = 1e-6f;
constexpr float QSCALE = 0.10206207261596575f * 1.4426950408889634f;
constexpr float DFT_NORM = 0.0013810679320049757f;

constexpr size_t MiB = 1u << 20;
constexpr size_t WS_CTL = 0, CTL_ZERO_BYTES = 1 * MiB;
constexpr size_t WS_PART = 1 * MiB;
constexpr size_t WS_MOD = 3 * MiB;
constexpr size_t WS_WIN = 4 * MiB;
constexpr size_t WS_WQB = 10 * MiB;
constexpr size_t WS_WKVB = 10 * MiB + 512 * 1024;
constexpr size_t WS_WF = 11 * MiB;
constexpr size_t WS_WMO = 13 * MiB;
constexpr size_t WS_WOUT = 14 * MiB;
constexpr size_t WS_DFT = 16 * MiB;
constexpr size_t WS_FE = 32 * MiB;
constexpr size_t WS_FO = 40 * MiB;
constexpr size_t WS_HX = 50 * MiB;
constexpr size_t WS_FT = 84 * MiB;
constexpr size_t WS_QL = 100 * MiB;
constexpr size_t WS_KVK = 108 * MiB;
constexpr size_t WS_ATT = 100 * MiB;
constexpr size_t WS_GATES = 117 * MiB;
constexpr size_t WS_QR = 181 * MiB;
constexpr size_t WS_VT = 205 * MiB;
constexpr size_t WS_KF = 222 * MiB;
constexpr size_t WS_Y = 181 * MiB;
constexpr size_t WS_WUP = 248 * MiB;
constexpr size_t WS_WDOWN = 224 * MiB;
constexpr size_t WS_X1B = 16 * MiB;
constexpr size_t WS_RS2 = 128 * 1024;
constexpr size_t WS_BIAS2 = 192 * 1024;
constexpr size_t WS_U = 82 * MiB;
constexpr size_t WS_END = 256 * MiB;
static_assert(WS_KF + (size_t)NB * NH * NKEY * DQK * 2 <= 248 * MiB && WS_U + (size_t)MT * DFF * 2 <= WS_WDOWN, "ws map");

constexpr int CW_TMO = 0;
constexpr int CW_BAR = 4096;
constexpr int CW_ATTQ = 8192;

constexpr int RING_OFF = 0, RING_BYTES = 131072;
constexpr int LDSCTL_OFF = RING_BYTES, MISC_OFF = LDSCTL_OFF + 320, TAB_OFF = RING_BYTES + 1024;
constexpr int LDS_BYTES = 147456;

__device__ __forceinline__ float bflo(unsigned w) { return __uint_as_float(w << 16); }
__device__ __forceinline__ float bfhi(unsigned w) { return __uint_as_float(w & 0xffff0000u); }
__device__ __forceinline__ float bf2f(bf16 b) { return __uint_as_float((unsigned)b << 16); }
typedef float f32x2_t __attribute__((ext_vector_type(2))); typedef __bf16 bf16x2_t __attribute__((ext_vector_type(2)));
__device__ __forceinline__ unsigned pk2(float lo, float hi) { f32x2_t v = {lo, hi}; bf16x2_t b = __builtin_convertvector(v, bf16x2_t); return __builtin_bit_cast(unsigned, b); }
__device__ __forceinline__ v4u pk8(const f32x4 a, const f32x4 b) { v4u w; w.x = pk2(a[0], a[1]); w.y = pk2(a[2], a[3]); w.z = pk2(b[0], b[1]); w.w = pk2(b[2], b[3]); return w; }
__device__ __forceinline__ float wave_sum(float v) {
#pragma unroll
    for (int o = 1; o < 64; o <<= 1) v += __shfl_xor(v, o);
    return v;
}
__device__ __forceinline__ float sigmoidf_fast(float x) { return __builtin_amdgcn_rcpf(1.0f + __builtin_amdgcn_exp2f(-1.4426950408889634f * x)); }

#define EPI_IDS() int t__ = threadIdx.x; asm volatile("" : "+v"(t__)); const int fr = t__ & 15, fq = (t__ >> 4) & 3, wid__ = __builtin_amdgcn_readfirstlane(t__ >> 6), wr = wid__ >> 2, wc = wid__ & 3; (void)wr_; (void)wc_; (void)fr_; (void)fq_
typedef const pg8::f32x4 (&AccRef)[2][2][4][2];
struct OneUnit { int pm, pn;
    __device__ __forceinline__ bool next(int i, pg8::Unit& u) const { if (i != 0) return false; u.pm = pm; u.pn = pn; return true; }
    __device__ __forceinline__ void a_ready(const pg8::Unit&) const {}
    __device__ __forceinline__ void done(const pg8::Unit&) const {}
};
__device__ __forceinline__ void row_to_bkey(int row, int& b, int& key) {
    if (row < MT) { b = row >> 12; key = row & 4095; } else { const int rr = row - MT; b = rr >> 8; key = SEQ + (rr & 255); }
}

__device__ __forceinline__ void store_t8(bf16* p  , size_t cstride, const v4u w, int odd) {
    const unsigned s0 = odd ? w.x : w.z, s1 = odd ? w.y : w.w;
    const unsigned r0 = __shfl_xor(s0, 1), r1 = __shfl_xor(s1, 1);
    const unsigned a0 = odd ? r0 : w.x, a1 = odd ? r1 : w.y;
    const unsigned b0 = odd ? w.z : r0, b1 = odd ? w.w : r1;
    bf16* q = odd ? (p - 1 + 4 * cstride) : p;
    *(unsigned*)(q + 0 * cstride) = (a0 & 0xffffu) | (b0 << 16); *(unsigned*)(q + 1 * cstride) = (a0 >> 16) | (b0 & 0xffff0000u);
    *(unsigned*)(q + 2 * cstride) = (a1 & 0xffffu) | (b1 << 16); *(unsigned*)(q + 3 * cstride) = (a1 >> 16) | (b1 & 0xffff0000u);
}
struct EpiInProj {
    static constexpr bool PERM = true, AFTER_DRAIN = false;
    bf16 *FT, *QL, *KVK, *GATES; const float* b_gate; int pn_off, rq;
    __device__ __forceinline__ void operator()(AccRef acc, const pg8::Unit& u0, int wr_, int wc_, int fr_, int fq_) const {
        EPI_IDS();
        pg8::Unit u; u.pm = u0.pm; u.pn = u0.pn + pn_off;
        const int row0 = u.pm * 256 + wr * 64 + fr, cw = wc * 32 + 8 * fq;
        if (u.pn < 2) {
#pragma unroll
            for (int ai = 0; ai < 2; ++ai)
#pragma unroll
                for (int m = 0; m < 4; ++m) { const int row = row0 + ai * 128 + m * 16; const int b = row >> 12, n = row & 4095;
#pragma unroll
                    for (int bj = 0; bj < 2; ++bj) { const int c0 = u.pn * 256 + bj * 128 + cw; bf16* p = FT + (((size_t)(b * 512 + c0)) << 12) + n;
                        store_t8(p, 4096, pk8(acc[ai][bj][m][0], acc[ai][bj][m][1]), fr & 1); } }
        } else if (u.pn < 4) {
            bf16* base = (u.pn == 2) ? QL : KVK;
#pragma unroll
            for (int ai = 0; ai < 2; ++ai) { if (rq >= 0 && ai * 2 + wr != rq) continue;
#pragma unroll
                for (int m = 0; m < 4; ++m) { const int row = row0 + ai * 128 + m * 16;
#pragma unroll
                    for (int bj = 0; bj < 2; ++bj) *(v4u*)(base + (size_t)row * 256 + bj * 128 + cw) = pk8(acc[ai][bj][m][0], acc[ai][bj][m][1]); } }
        } else {
            const int gc = (u.pn - 4) * 256 + cw;
#pragma unroll
            for (int bj = 0; bj < 2; ++bj) { const f32x4 b0 = *(const f32x4*)(b_gate + gc + bj * 128), b1 = *(const f32x4*)(b_gate + gc + bj * 128 + 4);
#pragma unroll
                for (int ai = 0; ai < 2; ++ai)
#pragma unroll
                    for (int m = 0; m < 4; ++m) { const int row = row0 + ai * 128 + m * 16; f32x4 v0 = acc[ai][bj][m][0] + b0, v1 = acc[ai][bj][m][1] + b1;
#pragma unroll
                        for (int e = 0; e < 4; ++e) { v0[e] = sigmoidf_fast(v0[e]); v1[e] = sigmoidf_fast(v1[e]); }
                        *(v4u*)(GATES + (size_t)row * 2048 + gc + bj * 128) = pk8(v0, v1); } }
        }
    }
};
template <int ACT  > struct EpiStore {
    static constexpr bool PERM = true, AFTER_DRAIN = false;
    bf16* O; int ldc;
    __device__ __forceinline__ void operator()(AccRef acc, const pg8::Unit& u, int wr_, int wc_, int fr_, int fq_) const {
        EPI_IDS();
        const int row0 = u.pm * 256 + wr * 64 + fr, c0 = u.pn * 256 + wc * 32 + 8 * fq;
#pragma unroll
        for (int ai = 0; ai < 2; ++ai)
#pragma unroll
            for (int m = 0; m < 4; ++m) { bf16* rp = O + (size_t)(row0 + ai * 128 + m * 16) * ldc + c0;
#pragma unroll
                for (int bj = 0; bj < 2; ++bj) { f32x4 v0 = acc[ai][bj][m][0], v1 = acc[ai][bj][m][1];
                    if (ACT == 1) {
#pragma unroll
                        for (int e = 0; e < 4; ++e) { const float a = fmaxf(v0[e], 0.f), b = fmaxf(v1[e], 0.f); v0[e] = a * a; v1[e] = b * b; } }
                    *(v4u*)(rp + bj * 128) = pk8(v0, v1); } }
    }
};
struct EpiKvUp {
    static constexpr bool PERM = true, AFTER_DRAIN = false;
    const bf16* KVK; bf16 *KF, *VT;
    __device__ __forceinline__ void operator()(AccRef acc, const pg8::Unit& u, int wr_, int wc_, int fr_, int fq_) const {
        EPI_IDS();
        const int row0 = u.pm * 256 + wr * 64 + fr;
#pragma unroll
        for (int ai = 0; ai < 2; ++ai) {
            v4u kw[4][4];
#pragma unroll
            for (int m = 0; m < 4; ++m) { const v4u* kp = (const v4u*)(KVK + (size_t)(row0 + ai * 128 + m * 16) * 256 + fq * 32);
#pragma unroll
                for (int i = 0; i < 4; ++i) kw[m][i] = kp[i]; }
            float rs[4];
#pragma unroll
            for (int m = 0; m < 4; ++m) { float s = 0.f;
#pragma unroll
                for (int i = 0; i < 4; ++i) { const v4u w = kw[m][i];
                    s += bflo(w.x) * bflo(w.x) + bfhi(w.x) * bfhi(w.x) + bflo(w.y) * bflo(w.y) + bfhi(w.y) * bfhi(w.y)
                       + bflo(w.z) * bflo(w.z) + bfhi(w.z) * bfhi(w.z) + bflo(w.w) * bflo(w.w) + bfhi(w.w) * bfhi(w.w); }
                s += __shfl_xor(s, 16); s += __shfl_xor(s, 32);
                rs[m] = __builtin_amdgcn_rsqf(s * (1.0f / 128.0f) + EPS); }
#pragma unroll
            for (int m = 0; m < 4; ++m) { const int row = row0 + ai * 128 + m * 16;
                int b, key; row_to_bkey(row, b, key);
#pragma unroll
                for (int bj = 0; bj < 2; ++bj) { const int head = 2 * u.pn + bj; const f32x4 v0 = acc[ai][bj][m][0] * rs[m], v1 = acc[ai][bj][m][1] * rs[m]; const v4u w = pk8(v0, v1);
                    if (wc < 2) { *(v4u*)(KF + ((size_t)((b * NH + head) * NKEY + key)) * DQK + wc * 32 + 8 * fq) = w; }
                    else { bf16* p = VT + ((size_t)((b * NH + head) * DV + (wc - 2) * 32 + 8 * fq)) * NKEY + key; store_t8(p, NKEY, w, fr & 1); } } }
            asm volatile("" ::: "memory"); }
    }
};
struct EpiDft {
    static constexpr bool PERM = true, AFTER_DRAIN = false;
    bf16* PM; const bf16* FT; int b;
    __device__ __forceinline__ void operator()(AccRef acc, const pg8::Unit& u, int wr_, int wc_, int fr_, int fq_) const {
        EPI_IDS();
        const int row0 = u.pm * 256 + wr * 64 + fr; const int s = u.pm >> 3;
        float t[2][8];
#pragma unroll
        for (int bj = 0; bj < 2; ++bj)
#pragma unroll
            for (int e = 0; e < 8; ++e) { const int col = u.pn * 256 + bj * 128 + wc * 32 + 8 * fq + e; t[bj][e] = s ? 0.f : bf2f(FT[((size_t)(b * 512 + col) << 12) + 2048]); }
#pragma unroll
        for (int ai = 0; ai < 2; ++ai)
#pragma unroll
            for (int m = 0; m < 4; ++m) { const int row = row0 + ai * 128 + m * 16; const int np = row & 2047; const float sg2 = (np & 1) ? -1.f : 1.f;
#pragma unroll
                for (int bj = 0; bj < 2; ++bj) { const int dc = (2 * u.pn + bj) * 256 + s * 128 + wc * 32 + 8 * fq;
                    f32x4 v0 = acc[ai][bj][m][0], v1 = acc[ai][bj][m][1];
#pragma unroll
                    for (int e = 0; e < 4; ++e) { v0[e] += sg2 * t[bj][e]; v1[e] += sg2 * t[bj][4 + e]; }
                    *(v4u*)(PM + ((size_t)(b * SEQ + np)) * 1024 + dc) = pk8(v0, v1);
                    if (np != 0) { const float sg = s ? -1.f : 1.f; *(v4u*)(PM + ((size_t)(b * SEQ + SEQ - np)) * 1024 + dc) = pk8(v0 * sg, v1 * sg); } } }
    }
};
struct EpiMerge1 {
    static constexpr bool PERM = true, AFTER_DRAIN = false;
    const bf16* GATES; bf16* Y;
    __device__ __forceinline__ void operator()(AccRef acc, const pg8::Unit& u, int wr_, int wc_, int fr_, int fq_) const {
        EPI_IDS();
        const int row0 = u.pm * 256 + wr * 64 + fr, c0 = u.pn * 256 + wc * 32 + 8 * fq;
#pragma unroll
        for (int ai = 0; ai < 2; ++ai)
#pragma unroll
            for (int m = 0; m < 4; ++m) { const int row = row0 + ai * 128 + m * 16;
#pragma unroll
                for (int bj = 0; bj < 2; ++bj) { const v4u g = *(const v4u*)(GATES + (size_t)row * 2048 + c0 + bj * 128);
                    f32x4 v0 = acc[ai][bj][m][0], v1 = acc[ai][bj][m][1];
                    v0[0] *= bflo(g.x); v0[1] *= bfhi(g.x); v0[2] *= bflo(g.y); v0[3] *= bfhi(g.y); v1[0] *= bflo(g.z); v1[1] *= bfhi(g.z); v1[2] *= bflo(g.w); v1[3] *= bfhi(g.w);
                    *(v4u*)(Y + (size_t)row * 1024 + c0 + bj * 128) = pk8(v0, v1); }
                if (m & 1) asm volatile("" ::: "memory"); }
    }
};
struct EpiMerge2 {
    static constexpr bool PERM = true, AFTER_DRAIN = false;
    const bf16* GATES; bf16* Y;
    __device__ __forceinline__ void operator()(AccRef acc, const pg8::Unit& u, int wr_, int wc_, int fr_, int fq_) const {
        EPI_IDS();
        const int row0 = u.pm * 256 + wr * 64 + fr, c0 = u.pn * 256 + wc * 32 + 8 * fq;
#pragma unroll
        for (int ai = 0; ai < 2; ++ai)
#pragma unroll
            for (int m = 0; m < 4; ++m) { const int row = row0 + ai * 128 + m * 16;
#pragma unroll
                for (int bj = 0; bj < 2; ++bj) { const v4u g = *(const v4u*)(GATES + (size_t)row * 2048 + 1024 + c0 + bj * 128);
                    bf16* yp = Y + (size_t)row * 1024 + c0 + bj * 128; const v4u t = *(const v4u*)yp;
                    f32x4 v0 = acc[ai][bj][m][0], v1 = acc[ai][bj][m][1];
                    v0[0] = v0[0] * bflo(g.x) + bflo(t.x); v0[1] = v0[1] * bfhi(g.x) + bfhi(t.x); v0[2] = v0[2] * bflo(g.y) + bflo(t.y); v0[3] = v0[3] * bfhi(g.y) + bfhi(t.y);
                    v1[0] = v1[0] * bflo(g.z) + bflo(t.z); v1[1] = v1[1] * bfhi(g.z) + bfhi(t.z); v1[2] = v1[2] * bflo(g.w) + bflo(t.w); v1[3] = v1[3] * bfhi(g.w) + bfhi(t.w);
                    *(v4u*)yp = pk8(v0, v1); }
                if (m & 1) asm volatile("" ::: "memory"); }
    }
};
struct EpiResid {
    static constexpr bool PERM = true, AFTER_DRAIN = false;
    const float* base; float* out; const float* gate;
    __device__ __forceinline__ void operator()(AccRef acc, const pg8::Unit& u, int wr_, int wc_, int fr_, int fq_) const {
        EPI_IDS();
        const int row0 = u.pm * 256 + wr * 64 + fr, c0 = u.pn * 256 + wc * 32 + 8 * fq; const int b = (u.pm * 256) >> 12;
        f32x4 gv[2][2];
#pragma unroll
        for (int bj = 0; bj < 2; ++bj)
#pragma unroll
            for (int n = 0; n < 2; ++n) gv[bj][n] = *(const f32x4*)(gate + (size_t)b * 6144 + c0 + bj * 128 + n * 4);
#pragma unroll
        for (int ai = 0; ai < 2; ++ai)
#pragma unroll
            for (int m = 0; m < 4; ++m) { const size_t off = (size_t)(row0 + ai * 128 + m * 16) * 1024 + c0;
#pragma unroll
                for (int bj = 0; bj < 2; ++bj)
#pragma unroll
                    for (int n = 0; n < 2; ++n) { const f32x4 bs = *(const f32x4*)(base + off + bj * 128 + n * 4);
                        *(f32x4*)(out + off + bj * 128 + n * 4) = bs + gv[bj][n] * acc[ai][bj][m][n]; }
                if (m & 1) asm volatile("" ::: "memory"); }
    }
};

struct EpiResidX {
    static constexpr bool PERM = true, AFTER_DRAIN = false;
    const float* base; float* out; const float* MODp; const float* n2g; bf16* XS; float* RS2;
    __device__ __forceinline__ void operator()(AccRef acc, const pg8::Unit& u, int wr_, int wc_, int fr_, int fq_) const {
        EPI_IDS();
        const int row0 = u.pm * 256 + wr * 64 + fr, c0 = u.pn * 256 + wc * 32 + 8 * fq; const int b = (u.pm * 256) >> 12;
        f32x4 gv[2][2], gs[2][2];
#pragma unroll
        for (int bj = 0; bj < 2; ++bj)
#pragma unroll
            for (int n = 0; n < 2; ++n) { const int c = c0 + bj * 128 + n * 4; gv[bj][n] = *(const f32x4*)(MODp + (size_t)b * 6144 + 2048 + c);
                gs[bj][n] = *(const f32x4*)(n2g + c) * (*(const f32x4*)(MODp + (size_t)b * 6144 + 4096 + c) + 1.0f); }
#pragma unroll
        for (int ai = 0; ai < 2; ++ai)
#pragma unroll
            for (int m = 0; m < 4; ++m) { const int row = row0 + ai * 128 + m * 16; const size_t off = (size_t)row * 1024 + c0; float ss = 0.f;
#pragma unroll
                for (int bj = 0; bj < 2; ++bj) { const f32x4 b0 = __builtin_nontemporal_load((const f32x4*)(base + off + bj * 128)), b1 = __builtin_nontemporal_load((const f32x4*)(base + off + bj * 128 + 4));
                    const f32x4 x0 = b0 + gv[bj][0] * acc[ai][bj][m][0], x1 = b1 + gv[bj][1] * acc[ai][bj][m][1];
                    *(f32x4*)(out + off + bj * 128) = x0; *(f32x4*)(out + off + bj * 128 + 4) = x1;
                    ss += ((x0[0] * x0[0] + x0[1] * x0[1]) + (x0[2] * x0[2] + x0[3] * x0[3])) + ((x1[0] * x1[0] + x1[1] * x1[1]) + (x1[2] * x1[2] + x1[3] * x1[3]));
                    *(v4u*)(XS + off + bj * 128) = pk8(x0 * gs[bj][0], x1 * gs[bj][1]); }
                ss += __shfl_xor(ss, 16); ss += __shfl_xor(ss, 32);
                if (fq == 0) atomicAdd(RS2 + row, ss);
                if (m & 1) asm volatile("" ::: "memory"); }
    }
};
struct EpiUp {
    static constexpr bool PERM = true, AFTER_DRAIN = false;
    bf16* O; const float* RS2; const float* BIAS2;
    __device__ __forceinline__ void operator()(AccRef acc, const pg8::Unit& u, int wr_, int wc_, int fr_, int fq_) const {
        EPI_IDS();
        const int row0 = u.pm * 256 + wr * 64 + fr, c0 = u.pn * 256 + wc * 32 + 8 * fq; const int b = (u.pm * 256) >> 12;
        f32x4 bv[2][2];
#pragma unroll
        for (int bj = 0; bj < 2; ++bj) { bv[bj][0] = *(const f32x4*)(BIAS2 + (size_t)b * 4096 + c0 + bj * 128); bv[bj][1] = *(const f32x4*)(BIAS2 + (size_t)b * 4096 + c0 + bj * 128 + 4); }
#pragma unroll
        for (int ai = 0; ai < 2; ++ai)
#pragma unroll
            for (int m = 0; m < 4; ++m) { const int row = row0 + ai * 128 + m * 16; const float rs = __builtin_amdgcn_rsqf(RS2[row] * (1.0f / 1024.0f) + EPS);
                bf16* rp = O + (size_t)row * DFF + c0;
#pragma unroll
                for (int bj = 0; bj < 2; ++bj) { f32x4 v0 = acc[ai][bj][m][0] * rs + bv[bj][0], v1 = acc[ai][bj][m][1] * rs + bv[bj][1];
#pragma unroll
                    for (int e = 0; e < 4; ++e) { const float a = fmaxf(v0[e], 0.f), c = fmaxf(v1[e], 0.f); v0[e] = a * a; v1[e] = c * c; }
                    *(v4u*)(rp + bj * 128) = pk8(v0, v1); } }
    }
};


struct Args;
struct Frame {
    LAS unsigned char* lds;
    volatile LAS unsigned* MISC;
    gu32* ctl;
    int tid, lane, wave, vcu, G, bx;
    unsigned char* ws;
    const __attribute__((address_space(4))) struct Args* ap;
};
struct Args { const float* in[21]; float* out; unsigned char* ws; int ph_lo, ph_hi, li, pad; };

__device__ __forceinline__ void transpose_item(const float* W, int K, int N, bf16* WT, int ldk, int drow, const float* rs, LAS float* scr, int kb, int nb, int lane) {
    const int k0 = 64 * kb, n0 = 32 * nb;
    float tv[32];
#pragma unroll
    for (int i = 0; i < 32; ++i) { const int kk = 2 * i + (lane >> 5); tv[i] = __builtin_nontemporal_load(W + (size_t)(k0 + kk) * N + n0 + (lane & 31)); }
#pragma unroll
    for (int i = 0; i < 32; ++i) { const int kk = 2 * i + (lane >> 5); scr[kk * 33 + (lane & 31)] = tv[i]; }
    LDS_WAIT(); asm volatile("" ::: "memory");
    const int c = lane & 7;
    float sc[8];
#pragma unroll
    for (int e = 0; e < 8; ++e) sc[e] = rs ? rs[k0 + 8 * c + e] : 1.0f;
#pragma unroll
    for (int j = 0; j < 4; ++j) { const int n = (lane >> 3) + 8 * j; const LAS float* s = scr + (8 * c) * 33 + n;
        v4u o; o.x = pk2(s[0 * 33] * sc[0], s[1 * 33] * sc[1]); o.y = pk2(s[2 * 33] * sc[2], s[3 * 33] * sc[3]); o.z = pk2(s[4 * 33] * sc[4], s[5 * 33] * sc[5]); o.w = pk2(s[6 * 33] * sc[6], s[7 * 33] * sc[7]);
        *(GAS v4u*)(WT + (size_t)(drow + n0 + n) * ldk + k0 + 8 * c) = o; }
    LDS_WAIT(); asm volatile("" ::: "memory");
}
__device__ __forceinline__ float silu_f(float x) { return x / (1.0f + __expf(-x)); }
__device__ __forceinline__ void ada_block(Frame& F, int cg) {
    const float* c = F.ap->in[1]; const float* c_ctx = F.ap->in[3]; const float* ada_w = F.ap->in[4]; const float* ada_b = F.ap->in[5];
    float* MOD = (float*)(F.ws + WS_MOD);
    const int lane = F.lane, col = cg * 64 + lane, k0 = F.wave * 128;
    float a[5];
#pragma unroll
    for (int r = 0; r < 5; ++r) a[r] = 0.f;
#pragma unroll
    for (int half = 0; half < 2; ++half) {
        float s[5];
#pragma unroll
        for (int r = 0; r < 4; ++r) s[r] = silu_f(c[r * 1024 + k0 + half * 64 + lane]);
        s[4] = silu_f(c_ctx[k0 + half * 64 + lane]);
        const float* wp = ada_w + (size_t)(k0 + half * 64) * 6144 + col;
        float wv[64];
#pragma unroll
        for (int kk = 0; kk < 64; ++kk) wv[kk] = __builtin_nontemporal_load(wp + (size_t)kk * 6144);
#pragma unroll
        for (int kk = 0; kk < 64; ++kk) {
#pragma unroll
            for (int r = 0; r < 5; ++r) a[r] += __shfl(s[r], kk) * wv[kk]; }
    }
    LAS float* part = (LAS float*)(F.lds + RING_OFF + 8 * 16384 - 16384);
    part = (LAS float*)(F.lds + TAB_OFF + 1024);
#pragma unroll
    for (int r = 0; r < 5; ++r) part[(F.wave * 5 + r) * 64 + lane] = a[r];
    __syncthreads();
    if (F.tid < 320) { const int r = F.tid >> 6, l = F.tid & 63; float v = ada_b[cg * 64 + l];
#pragma unroll
        for (int w = 0; w < 8; ++w) v += part[(w * 5 + r) * 64 + l];
        MOD[(size_t)r * 6144 + cg * 64 + l] = v; }
}
__device__ __forceinline__ void wf_item(const float* wf, bf16* WFT, const LAS float* tab, int item, int lane) {
    const int cb = item % 9, jb = (item / 9) & 15, g = item / 144; const int j = jb * 64 + lane, cbase = cb * 8;
    const float* wp = wf + (size_t)(g * 128) * 1024 + j;
    const float w0 = wp[0], w64 = wp[(size_t)64 * 1024];
    float ac[8], as[8];
#pragma unroll
    for (int i = 0; i < 8; ++i) { ac[i] = w0 + (((cbase + i) & 1) ? -w64 : w64); as[i] = 0.f; }
    for (int c0 = 1; c0 < 64; c0 += 21) { float fe[21], fo[21];
#pragma unroll
        for (int u = 0; u < 21; ++u) { const float a = wp[(size_t)(c0 + u) * 1024], b = wp[(size_t)(128 - c0 - u) * 1024]; fe[u] = a + b; fo[u] = a - b; }
#pragma unroll
        for (int u = 0; u < 21; ++u) { const int cp = c0 + u;
#pragma unroll
            for (int i = 0; i < 8; ++i) { const int idx = ((cbase + i) * cp) & 127; ac[i] += tab[idx] * fe[u]; as[i] += tab[128 + idx] * fo[u]; } } }
    bf16* op = WFT + (size_t)j * 1024 + g * 256;
    unsigned short hc[8], hs[8];
#pragma unroll
    for (int i = 0; i < 8; i += 2) { const unsigned a = pk2(ac[i] * DFT_NORM, ac[i + 1] * DFT_NORM), b = pk2(-as[i] * DFT_NORM, -as[i + 1] * DFT_NORM);
        hc[i] = (unsigned short)(a & 0xffffu); hc[i + 1] = (unsigned short)(a >> 16); hs[i] = (unsigned short)(b & 0xffffu); hs[i + 1] = (unsigned short)(b >> 16); }
    if (cb < 8) {
        v4u o; o.x = hc[0] | ((unsigned)hc[1] << 16); o.y = hc[2] | ((unsigned)hc[3] << 16); o.z = hc[4] | ((unsigned)hc[5] << 16); o.w = hc[6] | ((unsigned)hc[7] << 16);
        *(v4u*)(op + cbase) = o;
        o.x = hs[0] | ((unsigned)hs[1] << 16); o.y = hs[2] | ((unsigned)hs[3] << 16); o.z = hs[4] | ((unsigned)hs[5] << 16); o.w = hs[6] | ((unsigned)hs[7] << 16);
        *(v4u*)(op + 128 + cbase) = o;
#pragma unroll
        for (int i = 0; i < 8; ++i) { const int c = cbase + i; if (c != 0) { op[128 - c] = hc[i]; op[128 + 128 - c] = (unsigned short)(hs[i] ^ 0x8000u); } }
    } else { op[64] = hc[0]; op[128 + 64] = hs[0]; }
}
__device__ __forceinline__ void dft_item(bf16* DFT, int item, int lane) {
    const int chunk = item * 64 + lane; const int m = chunk >> 8, n0 = (chunk & 255) * 8; const int s = m >> 11, np = m & 2047;
    float v[8];
#pragma unroll
    for (int e = 0; e < 8; ++e) { const int idx = (np * (n0 + e)) & 4095; const float t = (float)idx * (1.0f / 4096.0f); v[e] = s ? __builtin_amdgcn_sinf(t) : __builtin_amdgcn_cosf(t); }
    v4u o; o.x = pk2(v[0], v[1]); o.y = pk2(v[2], v[3]); o.z = pk2(v[4], v[5]); o.w = pk2(v[6], v[7]);
    *(v4u*)(DFT + (size_t)m * 2048 + n0) = o;
}
__device__ __forceinline__ void fold_item(const bf16* FT, bf16* FE, bf16* FO, bf16* PM, LAS bf16* scr, int item, int lane) {
    const v4u* src = (const v4u*)(FT + (size_t)item * 4096);
#pragma unroll
    for (int i = 0; i < 8; ++i) ((LAS v4u*)scr)[lane + 64 * i] = src[lane + 64 * i];
    LDS_WAIT(); asm volatile("" ::: "memory");
    float alt = 0.f;
#pragma unroll
    for (int j = 0; j < 4; ++j) { const int n0 = (j * 64 + lane) * 8; float fe[8], fo[8];
#pragma unroll
        for (int e = 0; e < 8; ++e) { const int n = n0 + e; const float a = bf2f(scr[n]); const float bm = bf2f(scr[(4096 - n) & 4095]); fe[e] = (n == 0) ? a : a + bm; fo[e] = (n == 0) ? 0.f : a - bm;
            alt += (e & 1) ? -fe[e] : fe[e]; }
        v4u o; o.x = pk2(fe[0], fe[1]); o.y = pk2(fe[2], fe[3]); o.z = pk2(fe[4], fe[5]); o.w = pk2(fe[6], fe[7]);
        *(v4u*)(FE + (size_t)item * 2048 + n0) = o;
        o.x = pk2(fo[0], fo[1]); o.y = pk2(fo[2], fo[3]); o.z = pk2(fo[4], fo[5]); o.w = pk2(fo[6], fo[7]);
        *(v4u*)(FO + (size_t)item * 2048 + n0) = o; }
    alt = wave_sum(alt);
    if (lane == 0) { alt += bf2f(scr[2048]);
        const int b = item >> 9, col = item & 511; bf16* o = PM + ((size_t)(b * SEQ + 2048)) * 1024 + (col >> 7) * 256 + (col & 127);
        o[0] = (bf16)(pk2(alt, 0.f) & 0xffffu); o[128] = 0; }
    LDS_WAIT(); asm volatile("" ::: "memory");
}

__device__ __forceinline__ void p0_prep(Frame& F) {
    LAS float* tab = (LAS float*)(F.lds + TAB_OFF);
    if (F.tid < 128) { const float t = (float)F.tid * (1.0f / 128.0f); tab[F.tid] = __builtin_amdgcn_cosf(t); tab[128 + F.tid] = __builtin_amdgcn_sinf(t); }
    __syncthreads();
    LAS float* scr = (LAS float*)(F.lds + RING_OFF + F.wave * 16384);
    const int gw = F.vcu * 8 + F.wave, NGW = F.G * 8;
    unsigned char* ws = F.ws;
    if (F.bx < 96) ada_block(F, F.bx);
    constexpr int I_WIN = 16 * 93, I_WQB = 4 * 24, I_WKVB = 2 * 32, I_Z1 = 192, I_Z2 = 256;
    constexpr int NIT = I_WIN + I_WQB + I_WKVB + I_Z1 + I_Z2;
    for (int it = gw; it < NIT; it += NGW) {
        int r = it;
        if (r < I_WIN) { const int kb = r / 93, nb = r % 93; const int n0 = nb * 32; const int drow = (n0 < 928) ? 0 : 96;
            transpose_item(F.ap->in[8], 1024, DIN, (bf16*)(ws + WS_WIN), 1024, drow, nullptr, scr, kb, nb, F.lane); continue; } r -= I_WIN;
        if (r < I_WQB) { transpose_item(F.ap->in[12], 256, 768, (bf16*)(ws + WS_WQB), 256, 0, F.ap->in[11], scr, r / 24, r % 24, F.lane); continue; } r -= I_WQB;
        if (r < I_WKVB) { transpose_item(F.ap->in[14], 128, 1024, (bf16*)(ws + WS_WKVB), 256, 0, F.ap->in[13], scr, r / 32, r % 32, F.lane); continue; } r -= I_WKVB;
        if (r < I_Z1) { const int ch = r * 64 + F.lane; *(v4u*)(ws + WS_WIN + (size_t)928 * 2048 + (size_t)ch * 16) = (v4u){0u, 0u, 0u, 0u}; continue; } r -= I_Z1;
        { const int ch = r * 64 + F.lane; *(v4u*)(ws + WS_WKVB + (size_t)(ch >> 4) * 512 + 256 + (ch & 15) * 16) = (v4u){0u, 0u, 0u, 0u}; }
    }
}
__device__ __forceinline__ void bias2_item(const float* MODp, const float* w_up, float* BIAS2, int item, int lane) {
    const int cg = item & 63, kc = item >> 6, col = cg * 64 + lane, k0 = kc * 64;
    float s[4], a[4];
#pragma unroll
    for (int r = 0; r < 4; ++r) { s[r] = MODp[(size_t)r * 6144 + 3072 + k0 + lane]; a[r] = 0.f; }
    const float* wp = w_up + (size_t)k0 * 4096 + col;
    float wv[64];
#pragma unroll
    for (int kk = 0; kk < 64; ++kk) wv[kk] = wp[(size_t)kk * 4096];
#pragma unroll
    for (int kk = 0; kk < 64; ++kk) {
#pragma unroll
        for (int r = 0; r < 4; ++r) a[r] += __shfl(s[r], kk) * wv[kk]; }
#pragma unroll
    for (int r = 0; r < 4; ++r) atomicAdd(BIAS2 + (size_t)r * 4096 + col, a[r]);
}
__device__ __forceinline__ void prep_late(Frame& F, const int gw, const int NGW) {
    LAS float* tab = (LAS float*)(F.lds + TAB_OFF);
    LAS float* scr = (LAS float*)(F.lds + RING_OFF + F.wave * 16384);
    unsigned char* ws = F.ws;
    constexpr int I_WMO = 8 * 32, I_WOUT = 16 * 32, I_WF = 576, I_B2 = 1024, I_UP = 16 * 128, I_DFT = 16384;
    constexpr int NIT = I_WMO + I_WOUT + I_WF + I_B2 + I_UP + I_DFT;
    for (int it = gw; it < NIT; it += NGW) {
        int r = it;
        if (r < I_WMO) { transpose_item(F.ap->in[17], 512, 1024, (bf16*)(ws + WS_WMO), 512, 0, nullptr, scr, r / 32, r % 32, F.lane); continue; } r -= I_WMO;
        if (r < I_WOUT) { transpose_item(F.ap->in[18], 1024, 1024, (bf16*)(ws + WS_WOUT), 1024, 0, nullptr, scr, r / 32, r % 32, F.lane); continue; } r -= I_WOUT;
        if (r < I_WF) { wf_item(F.ap->in[10], (bf16*)(ws + WS_WF), tab, r, F.lane); continue; } r -= I_WF;
        if (r < I_B2) { bias2_item((const float*)(ws + WS_MOD), F.ap->in[19], (float*)(ws + WS_BIAS2), r, F.lane); continue; } r -= I_B2;
        if (r < I_UP) { transpose_item(F.ap->in[19], 1024, 4096, (bf16*)(ws + WS_WUP), 1024, 0, nullptr, scr, r / 128, r % 128, F.lane); continue; } r -= I_UP;
        dft_item((bf16*)(ws + WS_DFT), r, F.lane);
    }
}
__device__ __forceinline__ void p1_mod(Frame& F) {
    const float* PART = (const float*)(F.ws + WS_PART); float* MOD = (float*)(F.ws + WS_MOD);
    for (int o = F.vcu * 512 + F.tid; o < 5 * 6144; o += F.G * 512) { const int j = o % 6144, r = o / 6144; float v = F.ap->in[5][j];
#pragma unroll
        for (int kc = 0; kc < 16; ++kc) v += PART[(size_t)(kc * 5 + r) * 6144 + j];
        MOD[o] = v; }
}
__device__ __forceinline__ void norm_row_load(const float* xrow, int lane, f32x4 (&v)[4]) {
    const f32x4* xr = (const f32x4*)xrow + lane;
#pragma unroll
    for (int j = 0; j < 4; ++j) v[j] = __builtin_nontemporal_load(xr + 64 * j);
}
__device__ __forceinline__ void norm_row_finish(const f32x4 (&v)[4], const float* g, const float* sh, const float* sc, bf16* orow, int lane) {
    float s = 0.f;
#pragma unroll
    for (int j = 0; j < 4; ++j) s += (v[j].x * v[j].x + v[j].y * v[j].y) + (v[j].z * v[j].z + v[j].w * v[j].w);
    const float rstd = __builtin_amdgcn_rsqf(wave_sum(s) * (1.0f / 1024.0f) + EPS);
    unsigned long long* o8 = (unsigned long long*)orow + lane;
#pragma unroll
    for (int j = 0; j < 4; ++j) { const f32x4 gg = ((const f32x4*)g)[64 * j + lane], hh = ((const f32x4*)sh)[64 * j + lane], cc = ((const f32x4*)sc)[64 * j + lane];
        const f32x4 y = (v[j] * rstd * gg) * (cc + 1.0f) + hh;
        o8[64 * j] = (unsigned long long)pk2(y.x, y.y) | ((unsigned long long)pk2(y.z, y.w) << 32); }
}
__device__ __forceinline__ void norm_vecs(const float* g, const float* sh, const float* sc, int lane, f32x4 (&A)[4], f32x4 (&B)[4]) {
#pragma unroll
    for (int j = 0; j < 4; ++j) { const f32x4 gg = ((const f32x4*)g)[64 * j + lane], cc = ((const f32x4*)sc)[64 * j + lane]; A[j] = gg * (cc + 1.0f); B[j] = ((const f32x4*)sh)[64 * j + lane]; }
}
__device__ __forceinline__ void norm_row_finish_v(const f32x4 (&v)[4], const f32x4 (&A)[4], const f32x4 (&B)[4], bf16* orow, int lane) {
    float s = 0.f;
#pragma unroll
    for (int j = 0; j < 4; ++j) s += (v[j].x * v[j].x + v[j].y * v[j].y) + (v[j].z * v[j].z + v[j].w * v[j].w);
    const float rstd = __builtin_amdgcn_rsqf(wave_sum(s) * (1.0f / 1024.0f) + EPS);
    unsigned long long* o8 = (unsigned long long*)orow + lane;
#pragma unroll
    for (int j = 0; j < 4; ++j) { const f32x4 y = (v[j] * rstd) * A[j] + B[j];
        o8[64 * j] = (unsigned long long)pk2(y.x, y.y) | ((unsigned long long)pk2(y.z, y.w) << 32); }
}
__device__ __forceinline__ void norm_mod_row(const float* xrow, const float* g, const float* sh, const float* sc, bf16* orow, int lane) {
    f32x4 v[4]; norm_row_load(xrow, lane, v); norm_row_finish(v, g, sh, sc, orow, lane);
}
__device__ __forceinline__ void wdown_copy(Frame& F) {
    LAS float* scr = (LAS float*)(F.lds + RING_OFF + F.wave * 16384);
    const int gw = F.vcu * 8 + F.wave, NGW = F.G * 8;
    for (int it = gw; it < 64 * 32; it += NGW) transpose_item(F.ap->in[20], 4096, 1024, (bf16*)(F.ws + WS_WDOWN), 4096, 0, nullptr, scr, it / 32, it % 32, F.lane);
}

__device__ __forceinline__ void rope_cs(int n, int l8, float& cr, float& sr, float& cc, float& sc) {
    const float fr8[8] = {1.0f, 0.31622776601683794f, 0.1f, 0.031622776601683794f, 0.01f, 0.0031622776601683794f, 0.001f, 0.00031622776601683794f};
    float f = fr8[0];
#pragma unroll
    for (int i = 1; i < 8; ++i) f = (l8 == i) ? fr8[i] : f;
    const float INV2PI = 0.15915494309189535f;
    const float ar = (float)(n >> 6) * f * INV2PI, ac = (float)(n & 63) * f * INV2PI;
    const float arf = ar - floorf(ar), acf = ac - floorf(ac);
    cr = __builtin_amdgcn_cosf(arf); sr = __builtin_amdgcn_sinf(arf); cc = __builtin_amdgcn_cosf(acf); sc = __builtin_amdgcn_sinf(acf);
}
__device__ __forceinline__ float sumsq8(const v4u w) {
    return bflo(w.x) * bflo(w.x) + bfhi(w.x) * bfhi(w.x) + bflo(w.y) * bflo(w.y) + bfhi(w.y) * bfhi(w.y)
         + bflo(w.z) * bflo(w.z) + bfhi(w.z) * bfhi(w.z) + bflo(w.w) * bflo(w.w) + bfhi(w.w) * bfhi(w.w);
}
struct FinRow { v4u kv; float a1, a2, b1, b2; v4u qv; float qa1, qa2, qb1, qb2; float sq; };
__device__ __forceinline__ void finalize_load(Frame& F, int row, FinRow& R) {
    const int lane = F.lane, h = lane >> 3, l8 = lane & 7;
    const bf16* KF = (const bf16*)(F.ws + WS_KF); const bf16* KVK = (const bf16*)(F.ws + WS_KVK); const bf16* QR = (const bf16*)(F.ws + WS_QR); const bf16* QL = (const bf16*)(F.ws + WS_QL);
    int b, key; row_to_bkey(row, b, key);
    const bf16* kp = KF + ((size_t)((b * NH + h) * NKEY + key)) * DQK;
    R.kv = *(const v4u*)(kp + 8 * l8);
    const bf16* krp = KVK + (size_t)row * 256 + 128;
    R.a1 = bf2f(krp[l8]); R.a2 = bf2f(krp[8 + l8]); R.b1 = bf2f(krp[16 + l8]); R.b2 = bf2f(krp[24 + l8]);
    if (row < MT) {
        const v2u qw = *(const v2u*)(QL + (size_t)row * 256 + 4 * lane);
        R.sq = bflo(qw.x) * bflo(qw.x) + bfhi(qw.x) * bfhi(qw.x) + bflo(qw.y) * bflo(qw.y) + bfhi(qw.y) * bfhi(qw.y);
        const bf16* qp = QR + (size_t)row * 768 + h * DQK;
        R.qv = *(const v4u*)(qp + 8 * l8);
        R.qa1 = bf2f(qp[64 + l8]); R.qa2 = bf2f(qp[72 + l8]); R.qb1 = bf2f(qp[80 + l8]); R.qb2 = bf2f(qp[88 + l8]);
    }
}
__device__ __forceinline__ void finalize_store(Frame& F, int row, const FinRow& R) {
    const int lane = F.lane, h = lane >> 3, l8 = lane & 7;
    bf16* KF = (bf16*)(F.ws + WS_KF); bf16* QR = (bf16*)(F.ws + WS_QR);
    const float* q_gain = F.ap->in[15]; const float* k_gain = F.ap->in[16];
    int b, key; row_to_bkey(row, b, key);
    const bool lat = row < MT;
    float cr = 1.f, sr = 0.f, cc = 1.f, sc = 0.f;
    if (lat) rope_cs(key, l8, cr, sr, cc, sc);
    {
        bf16* kp = KF + ((size_t)((b * NH + h) * NKEY + key)) * DQK;
        const v4u kv = R.kv; float a1 = R.a1, a2 = R.a2, b1 = R.b1, b2 = R.b2;
        float ss = sumsq8(kv) + a1 * a1 + a2 * a2 + b1 * b1 + b2 * b2;
        ss += __shfl_xor(ss, 1); ss += __shfl_xor(ss, 2); ss += __shfl_xor(ss, 4);
        const float rk = __builtin_amdgcn_rsqf(ss * (1.0f / 96.0f) + EPS);
        const f32x4 g0 = *(const f32x4*)(k_gain + 8 * l8), g1 = *(const f32x4*)(k_gain + 8 * l8 + 4);
        v4u o; o.x = pk2(bflo(kv.x) * rk * g0[0], bfhi(kv.x) * rk * g0[1]); o.y = pk2(bflo(kv.y) * rk * g0[2], bfhi(kv.y) * rk * g0[3]);
        o.z = pk2(bflo(kv.z) * rk * g1[0], bfhi(kv.z) * rk * g1[1]); o.w = pk2(bflo(kv.w) * rk * g1[2], bfhi(kv.w) * rk * g1[3]);
        *(v4u*)(kp + 8 * l8) = o;
        a1 *= rk * k_gain[64 + l8]; a2 *= rk * k_gain[72 + l8]; b1 *= rk * k_gain[80 + l8]; b2 *= rk * k_gain[88 + l8];
        const float oa1 = a1 * cr - a2 * sr, oa2 = a2 * cr + a1 * sr, ob1 = b1 * cc - b2 * sc, ob2 = b2 * cc + b1 * sc;
        const unsigned w0 = pk2(oa1, oa2), w1 = pk2(ob1, ob2);
        kp[64 + l8] = (bf16)(w0 & 0xffffu); kp[72 + l8] = (bf16)(w0 >> 16); kp[80 + l8] = (bf16)(w1 & 0xffffu); kp[88 + l8] = (bf16)(w1 >> 16);
    }
    if (lat) {
        const float aq = __builtin_amdgcn_rsqf(wave_sum(R.sq) * (1.0f / 256.0f) + EPS);
        bf16* qp = QR + (size_t)row * 768 + h * DQK;
        const v4u qv = R.qv;
        float a1 = R.qa1 * aq, a2 = R.qa2 * aq, b1 = R.qb1 * aq, b2 = R.qb2 * aq;
        float ss = sumsq8(qv) * aq * aq + a1 * a1 + a2 * a2 + b1 * b1 + b2 * b2;
        ss += __shfl_xor(ss, 1); ss += __shfl_xor(ss, 2); ss += __shfl_xor(ss, 4);
        const float rq = __builtin_amdgcn_rsqf(ss * (1.0f / 96.0f) + EPS) * QSCALE; const float rqa = rq * aq;
        const f32x4 g0 = *(const f32x4*)(q_gain + 8 * l8), g1 = *(const f32x4*)(q_gain + 8 * l8 + 4);
        v4u o; o.x = pk2(bflo(qv.x) * rqa * g0[0], bfhi(qv.x) * rqa * g0[1]); o.y = pk2(bflo(qv.y) * rqa * g0[2], bfhi(qv.y) * rqa * g0[3]);
        o.z = pk2(bflo(qv.z) * rqa * g1[0], bfhi(qv.z) * rqa * g1[1]); o.w = pk2(bflo(qv.w) * rqa * g1[2], bfhi(qv.w) * rqa * g1[3]);
        a1 *= rq * q_gain[64 + l8]; a2 *= rq * q_gain[72 + l8]; b1 *= rq * q_gain[80 + l8]; b2 *= rq * q_gain[88 + l8];
        const float oa1 = a1 * cr - a2 * sr, oa2 = a2 * cr + a1 * sr, ob1 = b1 * cc - b2 * sc, ob2 = b2 * cc + b1 * sc;
        const unsigned w0 = pk2(oa1, oa2), w1 = pk2(ob1, ob2);
        *(v4u*)(qp + 8 * l8) = o;
        qp[64 + l8] = (bf16)(w0 & 0xffffu); qp[72 + l8] = (bf16)(w0 >> 16); qp[80 + l8] = (bf16)(w1 & 0xffffu); qp[88 + l8] = (bf16)(w1 >> 16);
    }
}
__device__ __forceinline__ void finalize_all(Frame& F) {
    const int gw = F.vcu * 8 + F.wave, NGW = F.G * 8;
    for (int base = gw; base < MA; base += 9 * NGW) {
        FinRow R[9];
#pragma unroll
        for (int i = 0; i < 9; ++i) { const int row = base + i * NGW; if (row < MA) finalize_load(F, row, R[i]); }
#pragma unroll
        for (int i = 0; i < 9; ++i) { const int row = base + i * NGW; if (row < MA) finalize_store(F, row, R[i]); }
    }
}
__device__ __forceinline__ void nyquist_item(Frame& F, int item) {
    const bf16* FT = (const bf16*)(F.ws + WS_FT); bf16* PM = (bf16*)(F.ws + WS_HX);
    const v4u* p = (const v4u*)(FT + (size_t)item * 4096) + F.lane; float s = 0.f;
#pragma unroll
    for (int i = 0; i < 8; ++i) { const v4u w = p[64 * i]; s += (bflo(w.x) - bfhi(w.x)) + (bflo(w.y) - bfhi(w.y)) + (bflo(w.z) - bfhi(w.z)) + (bflo(w.w) - bfhi(w.w)); }
    s = wave_sum(s);
    if (F.lane == 0) { const int b = item >> 9, col = item & 511; bf16* o = PM + ((size_t)(b * SEQ + 2048)) * 1024 + (col >> 7) * 256 + (col & 127);
        o[0] = (bf16)(pk2(s, 0.f) & 0xffffu); o[128] = 0; }
}


constexpr int AT_KROW = 208, AT_VROW = 144;
constexpr int AT_KT = 64 * AT_KROW, AT_VT = 64 * AT_VROW;
constexpr int AT_STAGE = 2 * AT_KT + 2 * AT_VT;
static_assert(2 * AT_STAGE <= RING_BYTES, "attention LDS");
__device__ __forceinline__ f32x16 mfma32(bf16x8 a, bf16x8 b, f32x16 c) { return __builtin_amdgcn_mfma_f32_32x32x16_bf16(a, b, c, 0, 0, 0); }

#ifdef DBG_NOEXP
#define AT_EXP(x) ((x) * 0.001f)
#else
#define AT_EXP(x) __builtin_amdgcn_exp2f(x)
#endif
constexpr int AT_KST = 2 * AT_KT, AT_VST = 2 * AT_VT, AT_VBASE = 2 * AT_KST;
__device__ __forceinline__ void attn_unit(Frame& F, int bh, int qb, const float negM) {
    const bf16* QR = (const bf16*)(F.ws + WS_QR); const bf16* KF = (const bf16*)(F.ws + WS_KF); const bf16* VT = (const bf16*)(F.ws + WS_VT); bf16* ATT = (bf16*)(F.ws + WS_ATT);
    const int tid = F.tid, lane = F.lane, wave = F.wave, qg = wave & 3, kh = wave >> 2, r = lane & 31, hh = lane >> 5;
    const int b = bh >> 3, h = bh & 7;
    const int tok = b * SEQ + qb * 128 + qg * 32 + r;
    bf16x8 qf[6];
    { const bf16* qp = QR + (size_t)tok * 768 + h * DQK + 8 * hh;
#pragma unroll
      for (int ks = 0; ks < 6; ++ks) qf[ks] = *(const bf16x8*)(qp + 16 * ks); }
    const unsigned char* kg = (const unsigned char*)(KF + (size_t)bh * NKEY * DQK);
    const unsigned char* vg = (const unsigned char*)(VT + (size_t)bh * DV * NKEY);
    int kso[3], kdo[3], vso[2], vdo[2];
#pragma unroll
    for (int i = 0; i < 3; ++i) { const int c = tid + 512 * i; const int key = c / 12, part = c % 12; kso[i] = c * 16; kdo[i] = (key >> 6) * AT_KT + (key & 63) * AT_KROW + part * 16; }
#pragma unroll
    for (int i = 0; i < 2; ++i) { const int c = tid + 512 * i; const int dv = c >> 4, part = c & 15; vso[i] = dv * (NKEY * 2) + part * 16; vdo[i] = AT_VBASE + (part >> 3) * AT_VT + dv * AT_VROW + (part & 7) * 16; }
    v4u sk[3], sv[2];
    LAS unsigned char* const L = F.lds + RING_OFF;
#define AT_LOADK(pair) do { _Pragma("unroll") for (int i = 0; i < 3; ++i) sk[i] = *(const v4u*)(kg + (size_t)(pair) * (128 * 192) + kso[i]); } while (0)
#define AT_LOADV(pair) do { _Pragma("unroll") for (int i = 0; i < 2; ++i) sv[i] = *(const v4u*)(vg + (size_t)(pair) * 256 + vso[i]); } while (0)
#define AT_WRITEK(st) do { _Pragma("unroll") for (int i = 0; i < 3; ++i) *(LAS v4u*)(L + (st) * AT_KST + kdo[i]) = sk[i]; } while (0)
#define AT_WRITEV(st) do { _Pragma("unroll") for (int i = 0; i < 2; ++i) *(LAS v4u*)(L + (st) * AT_VST + vdo[i]) = sv[i]; } while (0)
    const int pr = (r & 0x13) | ((r & 4) << 1) | ((r & 8) >> 1);
    const int koff = kh * AT_KT + pr * AT_KROW + 16 * hh, voff = AT_VBASE + kh * AT_VT + r * AT_VROW + 16 * hh;
    {
        v4u sk1[3];
        AT_LOADK(0); AT_LOADV(0);
#pragma unroll
        for (int i = 0; i < 3; ++i) sk1[i] = *(const v4u*)(kg + (size_t)(128 * 192) + kso[i]);
        AT_WRITEK(0); AT_WRITEV(0);
#pragma unroll
        for (int i = 0; i < 3; ++i) *(LAS v4u*)(L + AT_KST + kdo[i]) = sk1[i];
    }
    __syncthreads();
    f32x16 s0, s1, o0, o1;
#pragma unroll
    for (int i = 0; i < 16; ++i) { s0[i] = negM; s1[i] = negM; o0[i] = 0.f; o1[i] = 0.f; }
#pragma unroll
    for (int ks = 0; ks < 6; ++ks) {
        const bf16x8 k0 = *(const LAS bf16x8*)(L + koff + ks * 32), k1 = *(const LAS bf16x8*)(L + koff + 32 * AT_KROW + ks * 32);
        s0 = mfma32(k0, qf[ks], s0); s1 = mfma32(k1, qf[ks], s1);
    }
    __syncthreads();
    float lrun = 0.f;
    constexpr int NPAIR = NKEY / 128;
    f32x16 n0, n1;
    for (int it2 = 0; it2 < NPAIR; it2 += 2) {
        {
        { const int pk_ = ((it2) + 2 < NPAIR) ? (it2) + 2 : NPAIR - 1, pv_ = ((it2) + 1 < NPAIR) ? (it2) + 1 : NPAIR - 1; AT_LOADK(pk_); AT_LOADV(pv_); }
        const LAS unsigned char* kb = L + (((it2) + 1) & 1) * AT_KST + koff;
        const LAS unsigned char* vb = L + ((it2) & 1) * AT_VST + voff;
        bf16x8 kfa[3], kfb[3], vfa[2], vfb[2];
#pragma unroll
        for (int ks = 0; ks < 3; ++ks) { kfa[ks] = *(const LAS bf16x8*)(kb + ks * 32); kfb[ks] = *(const LAS bf16x8*)(kb + 32 * AT_KROW + ks * 32); }
#pragma unroll
        for (int j = 0; j < 2; ++j) { vfa[j] = *(const LAS bf16x8*)(vb + 32 * j); vfb[j] = *(const LAS bf16x8*)(vb + 32 * AT_VROW + 32 * j); }
        __builtin_amdgcn_sched_barrier(0);
        __builtin_amdgcn_s_setprio(1);
#pragma unroll
        for (int i = 0; i < 16; ++i) { n0[i] = negM; n1[i] = negM; }
#pragma unroll
        for (int ks = 0; ks < 3; ++ks) { n0 = mfma32(kfa[ks], qf[ks], n0); n1 = mfma32(kfb[ks], qf[ks], n1); }
        float ps = 0.f;
#pragma unroll
        for (int i = 0; i < 16; ++i) { s0[i] = AT_EXP(s0[i]); ps += s0[i]; }
        bf16x8 p00, p01, p10, p11;
        { v4u w; w.x = pk2(s0[0], s0[1]); w.y = pk2(s0[2], s0[3]); w.z = pk2(s0[4], s0[5]); w.w = pk2(s0[6], s0[7]); p00 = __builtin_bit_cast(bf16x8, w);
          w.x = pk2(s0[8], s0[9]); w.y = pk2(s0[10], s0[11]); w.z = pk2(s0[12], s0[13]); w.w = pk2(s0[14], s0[15]); p01 = __builtin_bit_cast(bf16x8, w); }
        __builtin_amdgcn_sched_barrier(0);
#pragma unroll
        for (int ks = 0; ks < 3; ++ks) { kfa[ks] = *(const LAS bf16x8*)(kb + (ks + 3) * 32); kfb[ks] = *(const LAS bf16x8*)(kb + 32 * AT_KROW + (ks + 3) * 32); }
        o0 = mfma32(vfa[0], p00, o0); o1 = mfma32(vfb[0], p00, o1);
        o0 = mfma32(vfa[1], p01, o0); o1 = mfma32(vfb[1], p01, o1);
#pragma unroll
        for (int j = 0; j < 2; ++j) { vfa[j] = *(const LAS bf16x8*)(vb + 32 * (j + 2)); vfb[j] = *(const LAS bf16x8*)(vb + 32 * AT_VROW + 32 * (j + 2)); }
#pragma unroll
        for (int i = 0; i < 16; ++i) { s1[i] = AT_EXP(s1[i]); ps += s1[i]; }
        lrun += ps;
        { v4u w; w.x = pk2(s1[0], s1[1]); w.y = pk2(s1[2], s1[3]); w.z = pk2(s1[4], s1[5]); w.w = pk2(s1[6], s1[7]); p10 = __builtin_bit_cast(bf16x8, w);
          w.x = pk2(s1[8], s1[9]); w.y = pk2(s1[10], s1[11]); w.z = pk2(s1[12], s1[13]); w.w = pk2(s1[14], s1[15]); p11 = __builtin_bit_cast(bf16x8, w); }
        __builtin_amdgcn_sched_barrier(0);
#pragma unroll
        for (int ks = 0; ks < 3; ++ks) { n0 = mfma32(kfa[ks], qf[ks + 3], n0); n1 = mfma32(kfb[ks], qf[ks + 3], n1); }
        o0 = mfma32(vfa[0], p10, o0); o1 = mfma32(vfb[0], p10, o1);
        o0 = mfma32(vfa[1], p11, o0); o1 = mfma32(vfb[1], p11, o1);
        __builtin_amdgcn_s_setprio(0);
        __builtin_amdgcn_sched_barrier(0);
        AT_WRITEK((it2) & 1);
        AT_WRITEV(((it2) + 1) & 1);
        __syncthreads();
        }
        {
        { const int pk_ = ((it2 + 1) + 2 < NPAIR) ? (it2 + 1) + 2 : NPAIR - 1, pv_ = ((it2 + 1) + 1 < NPAIR) ? (it2 + 1) + 1 : NPAIR - 1; AT_LOADK(pk_); AT_LOADV(pv_); }
        const LAS unsigned char* kb = L + (((it2 + 1) + 1) & 1) * AT_KST + koff;
        const LAS unsigned char* vb = L + ((it2 + 1) & 1) * AT_VST + voff;
        bf16x8 kfa[3], kfb[3], vfa[2], vfb[2];
#pragma unroll
        for (int ks = 0; ks < 3; ++ks) { kfa[ks] = *(const LAS bf16x8*)(kb + ks * 32); kfb[ks] = *(const LAS bf16x8*)(kb + 32 * AT_KROW + ks * 32); }
#pragma unroll
        for (int j = 0; j < 2; ++j) { vfa[j] = *(const LAS bf16x8*)(vb + 32 * j); vfb[j] = *(const LAS bf16x8*)(vb + 32 * AT_VROW + 32 * j); }
        __builtin_amdgcn_sched_barrier(0);
        __builtin_amdgcn_s_setprio(1);
#pragma unroll
        for (int i = 0; i < 16; ++i) { s0[i] = negM; s1[i] = negM; }
#pragma unroll
        for (int ks = 0; ks < 3; ++ks) { s0 = mfma32(kfa[ks], qf[ks], s0); s1 = mfma32(kfb[ks], qf[ks], s1); }
        float ps = 0.f;
#pragma unroll
        for (int i = 0; i < 16; ++i) { n0[i] = AT_EXP(n0[i]); ps += n0[i]; }
        bf16x8 p00, p01, p10, p11;
        { v4u w; w.x = pk2(n0[0], n0[1]); w.y = pk2(n0[2], n0[3]); w.z = pk2(n0[4], n0[5]); w.w = pk2(n0[6], n0[7]); p00 = __builtin_bit_cast(bf16x8, w);
          w.x = pk2(n0[8], n0[9]); w.y = pk2(n0[10], n0[11]); w.z = pk2(n0[12], n0[13]); w.w = pk2(n0[14], n0[15]); p01 = __builtin_bit_cast(bf16x8, w); }
        __builtin_amdgcn_sched_barrier(0);
#pragma unroll
        for (int ks = 0; ks < 3; ++ks) { kfa[ks] = *(const LAS bf16x8*)(kb + (ks + 3) * 32); kfb[ks] = *(const LAS bf16x8*)(kb + 32 * AT_KROW + (ks + 3) * 32); }
        o0 = mfma32(vfa[0], p00, o0); o1 = mfma32(vfb[0], p00, o1);
        o0 = mfma32(vfa[1], p01, o0); o1 = mfma32(vfb[1], p01, o1);
#pragma unroll
        for (int j = 0; j < 2; ++j) { vfa[j] = *(const LAS bf16x8*)(vb + 32 * (j + 2)); vfb[j] = *(const LAS bf16x8*)(vb + 32 * AT_VROW + 32 * (j + 2)); }
#pragma unroll
        for (int i = 0; i < 16; ++i) { n1[i] = AT_EXP(n1[i]); ps += n1[i]; }
        lrun += ps;
        { v4u w; w.x = pk2(n1[0], n1[1]); w.y = pk2(n1[2], n1[3]); w.z = pk2(n1[4], n1[5]); w.w = pk2(n1[6], n1[7]); p10 = __builtin_bit_cast(bf16x8, w);
          w.x = pk2(n1[8], n1[9]); w.y = pk2(n1[10], n1[11]); w.z = pk2(n1[12], n1[13]); w.w = pk2(n1[14], n1[15]); p11 = __builtin_bit_cast(bf16x8, w); }
        __builtin_amdgcn_sched_barrier(0);
#pragma unroll
        for (int ks = 0; ks < 3; ++ks) { s0 = mfma32(kfa[ks], qf[ks + 3], s0); s1 = mfma32(kfb[ks], qf[ks + 3], s1); }
        o0 = mfma32(vfa[0], p10, o0); o1 = mfma32(vfb[0], p10, o1);
        o0 = mfma32(vfa[1], p11, o0); o1 = mfma32(vfb[1], p11, o1);
        __builtin_amdgcn_s_setprio(0);
        __builtin_amdgcn_sched_barrier(0);
        AT_WRITEK((it2 + 1) & 1);
        AT_WRITEV(((it2 + 1) + 1) & 1);
        __syncthreads();
        }
    }
#undef AT_LOADK
#undef AT_LOADV
#undef AT_WRITEK
#undef AT_WRITEV
    lrun += __shfl_xor(lrun, 32);
    LAS float* mg = (LAS float*)(F.lds + RING_OFF) + (qg * 64 + lane);
    if (kh == 1) {
        mg[256] = lrun;
#pragma unroll
        for (int i = 0; i < 16; ++i) { mg[(2 + i) * 256] = o0[i]; mg[(18 + i) * 256] = o1[i]; }
    }
    __syncthreads();
    if (kh == 0) {
        const float inv = 1.0f / (lrun + mg[256]);
        bf16* op = ATT + (size_t)tok * 512 + h * DV + 4 * hh;
#pragma unroll
        for (int g = 0; g < 4; ++g) {
            float x0[4], x1[4];
#pragma unroll
            for (int e = 0; e < 4; ++e) { x0[e] = (o0[4 * g + e] + mg[(2 + 4 * g + e) * 256]) * inv; x1[e] = (o1[4 * g + e] + mg[(18 + 4 * g + e) * 256]) * inv; }
            v2u w; w.x = pk2(x0[0], x0[1]); w.y = pk2(x0[2], x0[3]); *(v2u*)(op + 8 * g) = w;
            w.x = pk2(x1[0], x1[1]); w.y = pk2(x1[2], x1[3]); *(v2u*)(op + 32 + 8 * g) = w;
        }
    }
}
__device__ __forceinline__ void attn_phase(Frame& F) {
    const unsigned x0 = xb_xcc_id() & 7u;
    float negM;
    {
        const float* qg_ = F.ap->in[15]; const float* kg_ = F.ap->in[16];
        float mq = fmaxf(fabsf(qg_[F.lane]), (F.lane < 32) ? fabsf(qg_[64 + F.lane]) : 0.f), mk = fmaxf(fabsf(kg_[F.lane]), (F.lane < 32) ? fabsf(kg_[64 + F.lane]) : 0.f);
#pragma unroll
        for (int o = 1; o < 64; o <<= 1) { mq = fmaxf(mq, __shfl_xor(mq, o)); mk = fmaxf(mk, __shfl_xor(mk, o)); }
        negM = -14.2f * mq * mk; }
    for (;;) {
        __syncthreads();
        if (F.tid == 0) { int unit = -1;
            for (unsigned d = 0; d < 8; ++d) { const unsigned x = (x0 + d) & 7u; gu32* hq = F.ctl + CW_ATTQ + 64 * x;
                if (__hip_atomic_load(hq, RLX_AGENT) >= 128u) continue;
                const unsigned j = __hip_atomic_fetch_add(hq, 1u, RLX_AGENT);
                if (j < 128u) { unit = (int)(x * 128u + j); break; } }
            F.MISC[16] = (unsigned)unit; }
        __syncthreads();
        const int unit = (int)F.MISC[16];
        if (unit < 0) break;
        const int x = unit >> 7, j = unit & 127;
        attn_unit(F, x + 8 * (j >> 5), j & 31, negM);
    }
}

#define AS4 __attribute__((address_space(4)))
#define PHASE_FRAME() Frame F; { int t_ = threadIdx.x; asm volatile("" : "+v"(t_)); F.tid = t_; F.lane = t_ & 63; F.wave = __builtin_amdgcn_readfirstlane(t_ >> 6); \
    int bx_ = blockIdx.x, g_ = gridDim.x; asm volatile("" : "+s"(bx_), "+s"(g_)); F.G = g_; F.bx = bx_; F.vcu = (g_ % 8 == 0) ? (bx_ % 8) * (g_ / 8) + bx_ / 8 : bx_; \
    const AS4 Args* ap_ = (const AS4 Args*)__builtin_amdgcn_kernarg_segment_ptr(); asm volatile("" : "+s"(ap_)); F.ap = ap_; F.ws = ap_->ws; F.ctl = (gu32*)(F.ws + WS_CTL); \
    F.lds = (LAS unsigned char*)lds; F.MISC = (volatile LAS unsigned*)(F.lds + MISC_OFF); } \
    unsigned char* const ws = F.ws; const float* const MOD = (const float*)(ws + WS_MOD); bf16* const HX = (bf16*)(ws + WS_HX); (void)MOD; (void)HX
#define ARG(i) (F.ap->in[i])
__global__ void __launch_bounds__(512, 2) mk_fwd(Args args_unused) {
    extern __shared__ __attribute__((aligned(16))) unsigned char lds[];
    int lo, hi;
    XcdBarrier bar;
    {
        PHASE_FRAME();
        for (int u = F.tid; u < 512 / 4; u += 512) ((LAS unsigned*)(F.lds + LDSCTL_OFF))[u] = 0u;
        __syncthreads();
        bar.bar = (unsigned*)(F.ctl + CW_BAR); bar.x = 0; bar.st = nullptr;
        if (N_LAUNCHES == 1) bar = xcd_barrier_post((unsigned*)(F.ctl + CW_BAR), F.MISC + 8);
        lo = F.ap->ph_lo; hi = F.ap->ph_hi;
    }
#define IN(k) (lo <= (k) && (k) < hi)
#ifdef DBG_TIME_PHASE
#ifndef DBG_TIME_END
#define DBG_TIME_END (DBG_TIME_PHASE + 1)
#endif
#ifndef DBG_TIME_Q
#define DBG_TIME_Q 8.0f
#endif
#define STAMP(k) do { if (blockIdx.x == 0 && threadIdx.x == 0) { const AS4 Args* q_ = (const AS4 Args*)__builtin_amdgcn_kernarg_segment_ptr(); ((unsigned long long*)(q_->ws + 65536))[(k)] = __builtin_amdgcn_s_memrealtime(); } } while (0)
#else
#define STAMP(k) do { } while (0)
#endif
#define SEAM(k) do { if (IN(k) && IN((k) + 1)) xcd_barrier(bar); STAMP((k) + 1); } while (0)
    STAMP(0);

    if (IN(0)) { PHASE_FRAME(); p0_prep(F); } if (IN(0) && IN(2)) xcd_barrier(bar); STAMP(1); STAMP(2);
    if (IN(2)) { PHASE_FRAME();
        if (F.bx < 16) {
            const int ct = F.bx >> 2, rq = F.bx & 3, r0 = ct * 256 + rq * 64 + F.wave * 8;
            { f32x4 mA[4], mB[4]; norm_vecs(ARG(6), MOD + 4 * 6144, MOD + 4 * 6144 + 1024, F.lane, mA, mB);
              f32x4 v[8][4];
#pragma unroll
              for (int u = 0; u < 8; ++u) norm_row_load(ARG(2) + (size_t)(r0 + u) * 1024, F.lane, v[u]);
#pragma unroll
              for (int u = 0; u < 8; ++u) norm_row_finish_v(v[u], mA, mB, HX + (size_t)(MT + r0 + u) * 1024, F.lane); }
            VM_WAIT(); __syncthreads();
            pg8::Gemm g{HX, (const bf16*)(ws + WS_WIN), MA, DINP, 1024}; OneUnit S{64 + ct, 3};
            EpiInProj E{(bf16*)(ws + WS_FT), (bf16*)(ws + WS_QL), (bf16*)(ws + WS_KVK), (bf16*)(ws + WS_GATES), ARG(9), 0, rq};
            pg8::gemm_phase<EpiInProj, OneUnit, true, true>(F.lds + RING_OFF, g, S, E);
        } else {
            const int gw = ((int)F.bx - 16) * 8 + F.wave, NGW = (F.G - 16) * 8;
            if ((NGW & 3) == 0) {
                const int bb = gw & 3, idx = gw >> 2, nper = NGW >> 2;
                f32x4 mA[4], mB[4]; norm_vecs(ARG(6), MOD + bb * 6144, MOD + bb * 6144 + 1024, F.lane, mA, mB);
                for (int r = idx; r < SEQ; r += 4 * nper) { f32x4 v[4][4];
#pragma unroll
                    for (int u = 0; u < 4; ++u) { const int rr = r + u * nper; if (rr < SEQ) norm_row_load(ARG(0) + (size_t)(bb * SEQ + rr) * 1024, F.lane, v[u]); }
#pragma unroll
                    for (int u = 0; u < 4; ++u) { const int rr = r + u * nper; if (rr < SEQ) norm_row_finish_v(v[u], mA, mB, HX + (size_t)(bb * SEQ + rr) * 1024, F.lane); } }
            } else
            for (int row = gw; row < MT; row += NGW) { const int b = row >> 12; norm_mod_row(ARG(0) + (size_t)row * 1024, ARG(6), MOD + b * 6144, MOD + b * 6144 + 1024, HX + (size_t)row * 1024, F.lane); }
            prep_late(F, gw, NGW);
        }
    } SEAM(2);
    if (IN(3)) { PHASE_FRAME();
        pg8::Gemm g{HX, (const bf16*)(ws + WS_WIN), MT, DINP, 1024}; pg8::StaticOrder S; S.init(MT, DINP, F.G, (int)F.bx);
        EpiInProj E{(bf16*)(ws + WS_FT), (bf16*)(ws + WS_QL), (bf16*)(ws + WS_KVK), (bf16*)(ws + WS_GATES), ARG(9), 0, -1};
        pg8::gemm_phase<EpiInProj, pg8::StaticOrder, true, true>(F.lds + RING_OFF, g, S, E);
    } SEAM(3);
    if (IN(4)) { { PHASE_FRAME();
        { pg8::Gemm g{(const bf16*)(ws + WS_KVK), (const bf16*)(ws + WS_WKVB), MA, 1024, 256}; pg8::StaticOrder S; S.init(MA, 1024, F.G, (int)F.bx);
          EpiKvUp E{(const bf16*)(ws + WS_KVK), (bf16*)(ws + WS_KF), (bf16*)(ws + WS_VT)};
          pg8::gemm_phase<EpiKvUp, pg8::StaticOrder, true, true>(F.lds + RING_OFF, g, S, E); }
        { pg8::Gemm g{(const bf16*)(ws + WS_QL), (const bf16*)(ws + WS_WQB), MT, 768, 256}; pg8::StaticOrder S; S.init(MT, 768, F.G, (int)(((unsigned)F.bx + 192u) % (unsigned)F.G));
          EpiStore<0> E{(bf16*)(ws + WS_QR), 768};
          pg8::gemm_phase<EpiStore<0>, pg8::StaticOrder, true, true>(F.lds + RING_OFF, g, S, E); }
        }
        { PHASE_FRAME();
          const int gw = F.vcu * 8 + F.wave, NGW = F.G * 8; LAS bf16* fscr = (LAS bf16*)(F.lds + RING_OFF + F.wave * 8192);
          for (int it = gw; it < NB * 512; it += NGW) fold_item((const bf16*)(ws + WS_FT), (bf16*)(ws + WS_FE), (bf16*)(ws + WS_FO), HX, fscr, it, F.lane); }
    } SEAM(4);
    if (IN(5)) { PHASE_FRAME();
        const int gw = F.vcu * 8 + F.wave, NGW = F.G * 8;
        finalize_all(F);
    } SEAM(5);
    if (IN(6)) { PHASE_FRAME();
        if (F.bx < 128) { const int uid = F.bx; const int b = uid >> 5; const int pm = (uid >> 1) & 15;
            pg8::Gemm g{(const bf16*)(ws + WS_DFT), (const bf16*)(ws + ((pm >> 3) ? WS_FO : WS_FE)) + (size_t)b * 512 * 2048, 4096, 512, 2048}; OneUnit S{pm, uid & 1};
            EpiDft E{HX, (const bf16*)(ws + WS_FT), b};
            pg8::gemm_phase<EpiDft, OneUnit, true, true>(F.lds + RING_OFF, g, S, E); }
        attn_phase(F);
    } SEAM(6);
    if (IN(7)) { PHASE_FRAME();
        { pg8::Gemm g{HX, (const bf16*)(ws + WS_WF), MT, 1024, 1024}; pg8::StaticOrder S; S.init(MT, 1024, F.G, (int)F.bx);
          EpiMerge1 E{(const bf16*)(ws + WS_GATES), (bf16*)(ws + WS_Y)};
          pg8::gemm_phase<EpiMerge1, pg8::StaticOrder, true, true>(F.lds + RING_OFF, g, S, E); }
        { pg8::Gemm g{(const bf16*)(ws + WS_ATT), (const bf16*)(ws + WS_WMO), MT, 1024, 512}; pg8::StaticOrder S; S.init(MT, 1024, F.G, (int)F.bx);
          EpiMerge2 E{(const bf16*)(ws + WS_GATES), (bf16*)(ws + WS_Y)};
          pg8::gemm_phase<EpiMerge2, pg8::StaticOrder, true, true>(F.lds + RING_OFF, g, S, E); }
    } SEAM(7);
    if (IN(8)) { PHASE_FRAME();
        pg8::Gemm g{(const bf16*)(ws + WS_Y), (const bf16*)(ws + WS_WOUT), MT, 1024, 1024}; pg8::StaticOrder S; S.init(MT, 1024, F.G, (int)F.bx);
        EpiResidX E{ARG(0), F.ap->out, MOD, ARG(7), HX, (float*)(ws + WS_RS2)};
        pg8::gemm_phase<EpiResidX, pg8::StaticOrder, true, true>(F.lds + RING_OFF, g, S, E);
    } SEAM(8);
    STAMP(10);
    if (IN(10)) { { PHASE_FRAME(); wdown_copy(F); }
        __syncthreads();
        PHASE_FRAME();
        pg8::Gemm g{HX, (const bf16*)(ws + WS_WUP), MT, DFF, 1024}; pg8::StaticOrder S; S.init(MT, DFF, F.G, (int)F.bx);
        EpiUp E{(bf16*)(ws + WS_U), (const float*)(ws + WS_RS2), (const float*)(ws + WS_BIAS2)};
        pg8::gemm_phase<EpiUp, pg8::StaticOrder, true, true>(F.lds + RING_OFF, g, S, E);
    } SEAM(10);
    if (IN(11)) { PHASE_FRAME();
        pg8::Gemm g{(const bf16*)(ws + WS_U), (const bf16*)(ws + WS_WDOWN), MT, 1024, DFF}; pg8::StaticOrder S; S.init(MT, 1024, F.G, (int)F.bx);
        EpiResid E{F.ap->out, F.ap->out, MOD + 5120};
        pg8::gemm_phase<EpiResid, pg8::StaticOrder, true, true>(F.lds + RING_OFF, g, S, E);
    }
#ifdef DBG_TIME_PHASE
    {
        STAMP(12);
        if (blockIdx.x == 0 && threadIdx.x == 0) { asm volatile("s_waitcnt vmcnt(0)" ::: "memory"); }
        xcd_barrier(bar);
        PHASE_FRAME();
        const unsigned long long* ts = (const unsigned long long*)(ws + 65536);
        const unsigned long long a0 = __hip_atomic_load(ts + DBG_TIME_PHASE, RLX_AGENT), a1 = __hip_atomic_load(ts + DBG_TIME_END, RLX_AGENT);
        const float val = floorf((float)(a1 - a0) * (0.01f / DBG_TIME_Q) + 0.5f) * (1000.0f * DBG_TIME_Q);
        float* o = F.ap->out;
        for (size_t i = (size_t)F.vcu * 512 + F.tid; i < (size_t)MT * 1024; i += (size_t)F.G * 512) o[i] = val;
    }
#endif
#ifdef DBG_DUMP_OFF
    {
        xcd_barrier(bar);
        PHASE_FRAME();
        const bf16* src = (const bf16*)(ws + (size_t)DBG_DUMP_OFF); float* o = F.ap->out;
        for (size_t i = (size_t)F.vcu * 512 + F.tid; i < (size_t)MT * 1024; i += (size_t)F.G * 512) o[i] = bf2f(src[i]);
    }
#endif
#undef IN
#undef SEAM
}

#ifndef DBG_LO
#define DBG_LO 0
#endif
#ifndef DBG_HI
#define DBG_HI N_PHASES
#endif
extern "C" void kernel_launch(void* const* d_in, const int* in_sizes, int n_in, void* d_out, int out_size, void* d_ws, size_t ws_size, hipStream_t stream) {
    static int grid = 0;
    if (grid == 0) {
        if (n_in != 21 || in_sizes[0] != MT * DM || out_size != MT * DM || ws_size < WS_END) { fprintf(stderr, "kernel_launch: unexpected shapes (n_in %d, in0 %d, out %d, ws %zu)\n", n_in, n_in > 0 ? in_sizes[0] : -1, out_size, ws_size); grid = -1; return; }
        int dev = 0, cus = 0, per_cu = 0;
        if (hipGetDevice(&dev) != hipSuccess || hipDeviceGetAttribute(&cus, hipDeviceAttributeMultiprocessorCount, dev) != hipSuccess) { grid = -1; return; }
        if (hipFuncSetAttribute((const void*)mk_fwd, hipFuncAttributeMaxDynamicSharedMemorySize, LDS_BYTES) != hipSuccess) { fprintf(stderr, "kernel_launch: hipFuncSetAttribute failed\n"); grid = -1; return; }
        if (hipOccupancyMaxActiveBlocksPerMultiprocessor(&per_cu, (const void*)mk_fwd, 512, LDS_BYTES) != hipSuccess || per_cu < 1) fprintf(stderr, "kernel_launch: occupancy query reports %d per CU\n", per_cu);
        (void)hipGetLastError();
        grid = cus;
        if (grid < 128) { fprintf(stderr, "kernel_launch: needs >= 128 CUs\n"); grid = -1; return; }
    }
    if (grid < 0) return;
    if (hipMemsetAsync((char*)d_ws + WS_CTL, 0, 256 * 1024, stream) != hipSuccess) return;
    Args a{};
    for (int i = 0; i < 21; ++i) a.in[i] = (const float*)d_in[i];
    a.out = (float*)d_out; a.ws = (unsigned char*)d_ws;
    for (int li = 0; li < N_LAUNCHES; ++li) {
        a.ph_lo = (N_LAUNCHES == 1) ? DBG_LO : li; a.ph_hi = (N_LAUNCHES == 1) ? DBG_HI : li + 1; a.li = li;
        hipLaunchKernelGGL(mk_fwd, dim3(grid), dim3(512), LDS_BYTES, stream, a);
        const hipError_t le = hipPeekAtLastError();
        if (le != hipSuccess) { fprintf(stderr, "kernel_launch: launch %d failed: %s\n", li, hipGetErrorName(le)); break; }
    }
}
```

```cpp
#include <hip/hip_runtime.h>
#include <cstdio>
#include <cstdint>
namespace pg8 {
#define PG8_LAS __attribute__((address_space(3)))
typedef unsigned short bf16_t;
typedef short bf16x8 __attribute__((ext_vector_type(8)));
typedef float f32x4 __attribute__((ext_vector_type(4)));
typedef unsigned u32x4 __attribute__((ext_vector_type(4)));
constexpr int BM = 256, BK = 64, HALF = 128, HTB = HALF * BK * 2  , STAGE_BYTES = 8 * HTB, NXCD = 8, WGM = 8;

__host__ __device__ __forceinline__ int lds_byte(int r, int c) { const int st = (r >> 4) * 2 + (c >> 5), rr = r & 15, cc = c & 31, ob = rr * 64 + cc * 2; return st * 1024 + (ob ^ (((ob >> 9) & 1) << 5)); }
__host__ __device__ __forceinline__ void stage_rc(int b, int& R, int& C) { const int st = b / 1024, sb = b % 1024, swz = sb ^ (((sb >> 9) & 1) << 5); R = (st >> 1) * 16 + swz / 64; C = (st & 1) * 32 + (swz % 64) / 2; }
__host__ __device__ __forceinline__ int perm32(int rho) { const int n = rho >> 4, i = rho & 15; return 8 * (i >> 2) + 4 * n + (i & 3); }

struct Unit { int pm, pn; };
struct Gemm { const bf16_t* A; const bf16_t* Bt; int M, N, K; };

struct StaticOrder {
    int nM, nN, nwg, G, c;
    __host__ __device__ void init(int M, int N, int G_, int c_) { nM = M / BM; nN = N / BM; nwg = nM * nN; G = G_; c = c_; }
    __host__ __device__ bool next(int i, Unit& u) const {
        const long L = (long)i * G + c; if (L >= nwg) return false;
        int wgid = (int)L; { const int q = nwg / NXCD, r = nwg % NXCD, xcd = wgid % NXCD, off = wgid / NXCD; wgid = (xcd < r ? xcd * (q + 1) : r * (q + 1) + (xcd - r) * q) + off; }
        const int nig = WGM * nN, gid = wgid / nig, fm = gid * WGM, gsz = (nM - fm) < WGM ? (nM - fm) : WGM;
        u.pm = fm + ((wgid % nig) % gsz); u.pn = (wgid % nig) / gsz; return true;
    }
    __device__ __forceinline__ void a_ready(const Unit&) const {}
    __device__ __forceinline__ void done(const Unit&) const {}
};

__device__ __forceinline__ unsigned cvt_pk_bf16(float lo, float hi) { unsigned r; asm volatile("v_cvt_pk_bf16_f32 %0, %1, %2" : "=v"(r) : "v"(lo), "v"(hi)); return r; }
template <class Epi, class Sched, bool ALIGN_EPI = false, bool SP2 = false>
__device__ __forceinline__ void gemm_phase(PG8_LAS unsigned char* lds, const Gemm g, const Sched& S, const Epi& E) {
    int tid_ = threadIdx.x; asm volatile("" : "+v"(tid_)); const int tid = tid_, wid = __builtin_amdgcn_readfirstlane(tid >> 6), lane = tid & 63, wr = wid >> 2, wc = wid & 3, fr = lane & 15, fq = lane >> 4;
    const int K = g.K, nt = K / BK;
    unsigned voffA[2], voffB[2];
#pragma unroll
    for (int i = 0; i < 2; ++i) { int R, C; stage_rc(tid * 16 + i * 8192, R, C); const int Rb = Epi::PERM ? ((R & ~31) + perm32(R & 31)) : R;
        voffA[i] = (unsigned)(R * K + C) * 2u; voffB[i] = (unsigned)(Rb * K + C) * 2u; }
    const size_t kstep = (size_t)(BK * 2);
    const size_t hstep = (size_t)HALF * K * 2;
    const size_t tstep = 2 * hstep;
    const unsigned ldsw = (unsigned)wid * 1024u;
    const int aoff = lds_byte(wr * 64 + fr, fq * 8), boff = lds_byte(wc * 32 + fr, fq * 8);
#define PG8_SA(b, h) (((b) * 2 + (h)) * HTB)
#define PG8_SB(b, h) ((4 + (b) * 2 + (h)) * HTB)
#define PG8_STAGE(bufoff, gbase, voff) do { _Pragma("unroll") for (int _i = 0; _i < 2; ++_i) \
        __builtin_amdgcn_global_load_lds((const unsigned*)((const char*)(gbase) + (voff)[_i]), (PG8_LAS unsigned*)(lds + (bufoff) + ldsw + _i * 8192), 16, 0, 0); } while (0)
#define PG8_LDA(dst, b, h) do { _Pragma("unroll") for (int m = 0; m < 4; ++m) _Pragma("unroll") for (int k = 0; k < 2; ++k) dst[m][k] = *(const PG8_LAS bf16x8*)(lds + PG8_SA(b, h) + aoff + m * 2048 + k * 1024); } while (0)
#define PG8_LDB(dst, b, h) do { _Pragma("unroll") for (int n = 0; n < 2; ++n) _Pragma("unroll") for (int k = 0; k < 2; ++k) dst[n][k] = *(const PG8_LAS bf16x8*)(lds + PG8_SB(b, h) + boff + n * 2048 + k * 1024); } while (0)
#define PG8_MMA(ai, bj, At, Bt) do { __builtin_amdgcn_s_setprio(1); _Pragma("unroll") for (int m = 0; m < 4; ++m) _Pragma("unroll") for (int n = 0; n < 2; ++n) _Pragma("unroll") for (int k = 0; k < 2; ++k) \
        acc[ai][bj][m][n] = __builtin_amdgcn_mfma_f32_16x16x32_bf16(Bt[n][k], At[m][k], acc[ai][bj][m][n], 0, 0, 0); __builtin_amdgcn_s_setprio(0); } while (0)
#define PG8_WAIT_V(n) asm volatile("s_waitcnt vmcnt(" #n ")" ::: "memory")
#define PG8_WAIT_L(n) asm volatile("s_waitcnt lgkmcnt(" #n ")" ::: "memory")
#define PG8_BAR __builtin_amdgcn_s_barrier()
#define PG8_SCHED __builtin_amdgcn_sched_barrier(0)
    Unit cur, nxt; int ui = 0;
    if (!S.next(0, cur)) return;
    f32x4 acc[2][2][4][2];
#pragma unroll
    for (int a = 0; a < 2; ++a)
#pragma unroll
        for (int b = 0; b < 2; ++b)
#pragma unroll
            for (int m = 0; m < 4; ++m)
#pragma unroll
                for (int n = 0; n < 2; ++n) acc[a][b][m][n] = (f32x4){0.f, 0.f, 0.f, 0.f};
    bf16x8 At[4][2], B0[2][2], B1[2][2];
    const char* cA = (const char*)g.A + (size_t)cur.pm * tstep; const char* cB = (const char*)g.Bt + (size_t)cur.pn * tstep;
    S.a_ready(cur);
    if constexpr (SP2) {
        PG8_STAGE(PG8_SB(0, 0), cB, voffB); PG8_STAGE(PG8_SB(0, 1), cB + hstep, voffB); PG8_STAGE(PG8_SA(0, 0), cA, voffA); PG8_STAGE(PG8_SA(0, 1), cA + hstep, voffA);
        if (wr == 1) PG8_BAR;
        PG8_WAIT_V(2); PG8_BAR;
        PG8_STAGE(PG8_SB(1, 0), cB + kstep, voffB); PG8_STAGE(PG8_SA(1, 0), cA + kstep, voffA); PG8_STAGE(PG8_SB(1, 1), cB + hstep + kstep, voffB);
        PG8_WAIT_V(6); PG8_BAR;
    } else {
        PG8_STAGE(PG8_SB(0, 0), cB, voffB); PG8_STAGE(PG8_SA(0, 0), cA, voffA); PG8_STAGE(PG8_SB(0, 1), cB + hstep, voffB); PG8_STAGE(PG8_SA(0, 1), cA + hstep, voffA);
        if (wr == 1) PG8_BAR;
        PG8_WAIT_V(4); PG8_BAR;
        PG8_STAGE(PG8_SB(1, 0), cB + kstep, voffB); PG8_STAGE(PG8_SA(1, 0), cA + kstep, voffA); PG8_STAGE(PG8_SB(1, 1), cB + hstep + kstep, voffB);
        PG8_WAIT_V(6); PG8_BAR;
    }
    for (;;) {
        const bool has_next = S.next(ui + 1, nxt);
        const char* nA = has_next ? (const char*)g.A + (size_t)nxt.pm * tstep : cA; const char* nB = has_next ? (const char*)g.Bt + (size_t)nxt.pn * tstep : cB;
        for (int t = 0; t < nt; t += 2) {
            const bool last = (t == nt - 2);
            const char* a1 = cA + (size_t)(t + 1) * kstep;
            const char* a2 = last ? nA : cA + (size_t)(t + 2) * kstep; const char* b2 = last ? nB : cB + (size_t)(t + 2) * kstep;
            const char* a3 = a2 + kstep; const char* b3 = b2 + kstep;
            if (last && has_next) S.a_ready(nxt);
            if constexpr (SP2) {
            PG8_LDB(B0, 0, 0); PG8_LDB(B1, 0, 1); PG8_SCHED; PG8_LDA(At, 0, 0); PG8_STAGE(PG8_SA(1, 1), a1 + hstep, voffA);
            PG8_WAIT_V(8); PG8_WAIT_L(0); PG8_BAR; PG8_MMA(0, 0, At, B0); PG8_MMA(0, 1, At, B1); PG8_BAR; PG8_SCHED;
            PG8_LDA(At, 0, 1); PG8_STAGE(PG8_SB(0, 0), b2, voffB); PG8_STAGE(PG8_SB(0, 1), b2 + hstep, voffB); PG8_STAGE(PG8_SA(0, 0), a2, voffA);
            PG8_WAIT_V(8); PG8_WAIT_L(0); PG8_BAR; PG8_MMA(1, 0, At, B0); PG8_MMA(1, 1, At, B1); PG8_BAR; PG8_SCHED;
            PG8_LDB(B0, 1, 0); PG8_LDB(B1, 1, 1); PG8_SCHED; PG8_LDA(At, 1, 0); PG8_STAGE(PG8_SA(0, 1), a2 + hstep, voffA);
            PG8_WAIT_V(8); PG8_WAIT_L(0); PG8_BAR; PG8_MMA(0, 0, At, B0); PG8_MMA(0, 1, At, B1); PG8_BAR; PG8_SCHED;
            PG8_LDA(At, 1, 1); PG8_STAGE(PG8_SB(1, 0), b3, voffB); PG8_STAGE(PG8_SB(1, 1), b3 + hstep, voffB); PG8_STAGE(PG8_SA(1, 0), a3, voffA);
            PG8_WAIT_V(8); PG8_WAIT_L(0); PG8_BAR; PG8_MMA(1, 0, At, B0); PG8_MMA(1, 1, At, B1); PG8_BAR; PG8_SCHED;
            } else {
            PG8_LDB(B0, 0, 0); PG8_SCHED; PG8_LDA(At, 0, 0); PG8_STAGE(PG8_SA(1, 1), a1 + hstep, voffA);
            PG8_WAIT_L(8); PG8_BAR; PG8_WAIT_L(0); PG8_MMA(0, 0, At, B0); PG8_BAR; PG8_SCHED;
            PG8_LDB(B1, 0, 1); PG8_STAGE(PG8_SB(0, 0), b2, voffB);
            PG8_BAR; PG8_WAIT_L(0); PG8_MMA(0, 1, At, B1); PG8_BAR;
            PG8_LDA(At, 0, 1); PG8_STAGE(PG8_SA(0, 0), a2, voffA);
            PG8_BAR; PG8_WAIT_L(0); PG8_MMA(1, 0, At, B0); PG8_BAR; PG8_SCHED;
            PG8_STAGE(PG8_SB(0, 1), b2 + hstep, voffB);
            PG8_WAIT_V(6); PG8_BAR; PG8_MMA(1, 1, At, B1); PG8_BAR;
            PG8_LDB(B0, 1, 0); PG8_SCHED; PG8_LDA(At, 1, 0); PG8_STAGE(PG8_SA(0, 1), a2 + hstep, voffA);
            PG8_WAIT_L(8); PG8_BAR; PG8_WAIT_L(0); PG8_MMA(0, 0, At, B0); PG8_BAR; PG8_SCHED;
            PG8_LDB(B1, 1, 1); PG8_STAGE(PG8_SB(1, 0), b3, voffB);
            PG8_BAR; PG8_WAIT_L(0); PG8_MMA(0, 1, At, B1); PG8_BAR;
            PG8_LDA(At, 1, 1); PG8_STAGE(PG8_SA(1, 0), a3, voffA);
            PG8_BAR; PG8_WAIT_L(0); PG8_MMA(1, 0, At, B0); PG8_BAR; PG8_SCHED;
            PG8_STAGE(PG8_SB(1, 1), b3 + hstep, voffB);
            PG8_WAIT_V(6); PG8_BAR; PG8_MMA(1, 1, At, B1); PG8_BAR;
            }
        }
        if constexpr (ALIGN_EPI) { if (wr == 0) PG8_BAR; }
        if constexpr (!Epi::AFTER_DRAIN) { E(acc, cur, wr, wc, fr, fq); S.done(cur); }
        if (!has_next) break;
#pragma unroll
        for (int a = 0; a < 2; ++a)
#pragma unroll
            for (int b = 0; b < 2; ++b)
#pragma unroll
                for (int m = 0; m < 4; ++m)
#pragma unroll
                    for (int n = 0; n < 2; ++n) acc[a][b][m][n] = (f32x4){0.f, 0.f, 0.f, 0.f};
        cur = nxt; cA = nA; cB = nB; ++ui;
        if constexpr (ALIGN_EPI) { if (wr == 1) PG8_BAR; }
    }
    PG8_WAIT_V(0);
    if constexpr (!ALIGN_EPI) { if (wr == 0) PG8_BAR; }
    PG8_BAR;
    if constexpr (Epi::AFTER_DRAIN) { E.fused(acc, cur, wr, wc, fr, fq, lds, wid, lane); S.done(cur); }
#undef PG8_SA
#undef PG8_SB
#undef PG8_STAGE
#undef PG8_LDA
#undef PG8_LDB
#undef PG8_MMA
#undef PG8_WAIT_V
#undef PG8_WAIT_L
#undef PG8_BAR
#undef PG8_SCHED
}
}

#define GAS __attribute__((address_space(1)))
#define LAS __attribute__((address_space(3)))
typedef unsigned short bf16;
typedef unsigned v4u __attribute__((ext_vector_type(4)));
typedef unsigned v2u __attribute__((ext_vector_type(2)));
typedef float f32x4 __attribute__((ext_vector_type(4)));
typedef float f32x16 __attribute__((ext_vector_type(16)));
typedef short bf16x8 __attribute__((ext_vector_type(8)));
typedef GAS unsigned gu32;
#define RLX_AGENT __ATOMIC_RELAXED, __HIP_MEMORY_SCOPE_AGENT
#define LDS_WAIT() asm volatile("s_waitcnt lgkmcnt(0)" ::: "memory")
#define VM_WAIT() asm volatile("s_waitcnt vmcnt(0)" ::: "memory")

#ifndef MK_N_LAUNCHES
#define MK_N_LAUNCHES 1
#endif
constexpr int N_PHASES = 12;
constexpr int N_LAUNCHES = MK_N_LAUNCHES;
#define XB_TMO      128
#define XB_XCNT(j)  (256  + 64 * (j))
#define XB_XSUB(j)  (1280 + 64 * (j))
#define XB_XGEN(j)  (2304 + 64 * (j))
#define XB_TOP      3328
#define XB_TOPGEN   3392
#define XCD_BAR_WORDS 3456
#define XB_SPIN_CAP (1u << 18)

__device__ __forceinline__ unsigned xb_ld(unsigned* p)              { return __hip_atomic_load(p, __ATOMIC_RELAXED, __HIP_MEMORY_SCOPE_AGENT); }
__device__ __forceinline__ unsigned xb_add(unsigned* p, unsigned v) { return __hip_atomic_fetch_add(p, v, __ATOMIC_RELAXED, __HIP_MEMORY_SCOPE_AGENT); }
__device__ __forceinline__ unsigned xb_xcc_id() { return (unsigned)__builtin_amdgcn_s_getreg((3 << 11) | 20) & 0xFu; }
#define XB_SPIN(cond, bar) do { unsigned _sp = 0; while (cond) { __builtin_amdgcn_s_sleep(1); \
    if ((++_sp & 255u) == 0u) { if (xb_ld(&(bar)[XB_TMO])) break; if (_sp > XB_SPIN_CAP) { atomicAdd(&(bar)[XB_TMO], 1u); break; } } } } while (0)

struct XcdBarrier {
    unsigned* bar; unsigned x;
    volatile LAS unsigned* st;
};

__device__ __forceinline__ XcdBarrier xcd_barrier_post(unsigned* bar, volatile LAS unsigned* st) {
    XcdBarrier b; b.bar = bar; b.x = xb_xcc_id(); b.st = st;
    if (threadIdx.x == 0) (void)xb_add(&bar[XB_XCNT(b.x)], 1u);
    return b;
}
__device__ __forceinline__ void xcd_barrier_complete(unsigned* bar, unsigned x, unsigned& nloc, unsigned& nx) {
    const unsigned G = gridDim.x * gridDim.y * gridDim.z;
    unsigned sum, cnt, mine, sp = 0u;
    for (;;) {
        sum = 0u; cnt = 0u; mine = 0u;
#pragma unroll
        for (unsigned j = 0; j < 16; ++j) { const unsigned c = xb_ld(&bar[XB_XCNT(j)]); sum += c; cnt += (c > 0u) ? 1u : 0u; mine = (j == x) ? c : mine; }
        if (sum == G) break;
        __builtin_amdgcn_s_sleep(1);
        if ((++sp & 255u) == 0u) { if (xb_ld(&bar[XB_TMO])) break; if (sp > XB_SPIN_CAP) { atomicAdd(&bar[XB_TMO], 1u); break; } }
    }
    nloc = mine > 0u ? mine : 1u; nx = cnt > 0u ? cnt : 1u;
}

__device__ __forceinline__ void xcd_barrier(const XcdBarrier& b) {
    asm volatile("s_waitcnt vmcnt(0)" ::: "memory");
    __syncthreads();
    if (threadIdx.x == 0) {
        unsigned* bar = b.bar;
        __builtin_amdgcn_s_waitcnt(0);
        unsigned nloc = b.st[0], nx = b.st[1];
        if (nloc == 0u) { xcd_barrier_complete(bar, b.x, nloc, nx); b.st[0] = nloc; b.st[1] = nx; }
        const unsigned old = xb_add(&bar[XB_XSUB(b.x)], 1u);
        const unsigned gen = old / nloc;
        if (old + 1u == (gen + 1u) * nloc) {
            __builtin_amdgcn_fence(__ATOMIC_RELEASE, "agent");
            asm volatile("s_waitcnt vmcnt(0)" ::: "memory");
            const unsigned og = xb_add(&bar[XB_TOP], 1u);
            const unsigned tg = og / nx;
            if (og + 1u == (tg + 1u) * nx) xb_add(&bar[XB_TOPGEN], 1u);
            else XB_SPIN(xb_ld(&bar[XB_TOPGEN]) == tg, bar);
            __builtin_amdgcn_fence(__ATOMIC_ACQUIRE, "agent");
            xb_add(&bar[XB_XGEN(b.x)], 1u);
            asm volatile("s_waitcnt vmcnt(0)" ::: "memory");
        } else {
            XB_SPIN(xb_ld(&bar[XB_XGEN(b.x)]) == gen, bar);
            __builtin_amdgcn_fence(__ATOMIC_ACQUIRE, "agent");
            asm volatile("s_waitcnt vmcnt(0)" ::: "memory");
        }
    }
    __syncthreads();
}

constexpr int NB = 4, SEQ = 4096, DM = 1024, MT = NB * SEQ, CTXL = 256, CT = NB * CTXL, MA = MT + CT;
constexpr int NH = 8, DQK = 96, DV = 64, NKEY = SEQ + CTXL;
constexpr int DIN = 2976, DINP = 3072, DFF = 4096;
constexpr float EPS = 1e-6f;
constexpr float QSCALE = 0.10206207261596575f * 1.4426950408889634f;
constexpr float DFT_NORM = 0.0013810679320049757f;

constexpr size_t MiB = 1u << 20;
constexpr size_t WS_CTL = 0, CTL_ZERO_BYTES = 1 * MiB;
constexpr size_t WS_PART = 1 * MiB;
constexpr size_t WS_MOD = 3 * MiB;
constexpr size_t WS_WIN = 4 * MiB;
constexpr size_t WS_WQB = 10 * MiB;
constexpr size_t WS_WKVB = 10 * MiB + 512 * 1024;
constexpr size_t WS_WF = 11 * MiB;
constexpr size_t WS_WMO = 13 * MiB;
constexpr size_t WS_WOUT = 14 * MiB;
constexpr size_t WS_DFT = 16 * MiB;
constexpr size_t WS_FE = 32 * MiB;
constexpr size_t WS_FO = 40 * MiB;
constexpr size_t WS_HX = 50 * MiB;
constexpr size_t WS_FT = 84 * MiB;
constexpr size_t WS_QL = 100 * MiB;
constexpr size_t WS_KVK = 108 * MiB;
constexpr size_t WS_ATT = 100 * MiB;
constexpr size_t WS_GATES = 117 * MiB;
constexpr size_t WS_QR = 181 * MiB;
constexpr size_t WS_VT = 205 * MiB;
constexpr size_t WS_KF = 222 * MiB;
constexpr size_t WS_Y = 181 * MiB;
constexpr size_t WS_WUP = 248 * MiB;
constexpr size_t WS_WDOWN = 224 * MiB;
constexpr size_t WS_X1B = 16 * MiB;
constexpr size_t WS_RS2 = 128 * 1024;
constexpr size_t WS_BIAS2 = 192 * 1024;
constexpr size_t WS_U = 82 * MiB;
constexpr size_t WS_END = 256 * MiB;
static_assert(WS_KF + (size_t)NB * NH * NKEY * DQK * 2 <= 248 * MiB && WS_U + (size_t)MT * DFF * 2 <= WS_WDOWN, "ws map");

constexpr int CW_TMO = 0;
constexpr int CW_BAR = 4096;
constexpr int CW_ATTQ = 8192;

constexpr int RING_OFF = 0, RING_BYTES = 131072;
constexpr int LDSCTL_OFF = RING_BYTES, MISC_OFF = LDSCTL_OFF + 320, TAB_OFF = RING_BYTES + 1024;
constexpr int LDS_BYTES = 147456;

__device__ __forceinline__ float bflo(unsigned w) { return __uint_as_float(w << 16); }
__device__ __forceinline__ float bfhi(unsigned w) { return __uint_as_float(w & 0xffff0000u); }
__device__ __forceinline__ float bf2f(bf16 b) { return __uint_as_float((unsigned)b << 16); }
typedef float f32x2_t __attribute__((ext_vector_type(2))); typedef __bf16 bf16x2_t __attribute__((ext_vector_type(2)));
__device__ __forceinline__ unsigned pk2(float lo, float hi) { f32x2_t v = {lo, hi}; bf16x2_t b = __builtin_convertvector(v, bf16x2_t); return __builtin_bit_cast(unsigned, b); }
__device__ __forceinline__ v4u pk8(const f32x4 a, const f32x4 b) { v4u w; w.x = pk2(a[0], a[1]); w.y = pk2(a[2], a[3]); w.z = pk2(b[0], b[1]); w.w = pk2(b[2], b[3]); return w; }
__device__ __forceinline__ float wave_sum(float v) {
#pragma unroll
    for (int o = 1; o < 64; o <<= 1) v += __shfl_xor(v, o);
    return v;
}
__device__ __forceinline__ float sigmoidf_fast(float x) { return __builtin_amdgcn_rcpf(1.0f + __builtin_amdgcn_exp2f(-1.4426950408889634f * x)); }

#define EPI_IDS() int t__ = threadIdx.x; asm volatile("" : "+v"(t__)); const int fr = t__ & 15, fq = (t__ >> 4) & 3, wid__ = __builtin_amdgcn_readfirstlane(t__ >> 6), wr = wid__ >> 2, wc = wid__ & 3; (void)wr_; (void)wc_; (void)fr_; (void)fq_
typedef const pg8::f32x4 (&AccRef)[2][2][4][2];
struct OneUnit { int pm, pn;
    __device__ __forceinline__ bool next(int i, pg8::Unit& u) const { if (i != 0) return false; u.pm = pm; u.pn = pn; return true; }
    __device__ __forceinline__ void a_ready(const pg8::Unit&) const {}
    __device__ __forceinline__ void done(const pg8::Unit&) const {}
};
__device__ __forceinline__ void row_to_bkey(int row, int& b, int& key) {
    if (row < MT) { b = row >> 12; key = row & 4095; } else { const int rr = row - MT; b = rr >> 8; key = SEQ + (rr & 255); }
}

__device__ __forceinline__ void store_t8(bf16* p  , size_t cstride, const v4u w, int odd) {
    const unsigned s0 = odd ? w.x : w.z, s1 = odd ? w.y : w.w;
    const unsigned r0 = __shfl_xor(s0, 1), r1 = __shfl_xor(s1, 1);
    const unsigned a0 = odd ? r0 : w.x, a1 = odd ? r1 : w.y;
    const unsigned b0 = odd ? w.z : r0, b1 = odd ? w.w : r1;
    bf16* q = odd ? (p - 1 + 4 * cstride) : p;
    *(unsigned*)(q + 0 * cstride) = (a0 & 0xffffu) | (b0 << 16); *(unsigned*)(q + 1 * cstride) = (a0 >> 16) | (b0 & 0xffff0000u);
    *(unsigned*)(q + 2 * cstride) = (a1 & 0xffffu) | (b1 << 16); *(unsigned*)(q + 3 * cstride) = (a1 >> 16) | (b1 & 0xffff0000u);
}
struct EpiInProj {
    static constexpr bool PERM = true, AFTER_DRAIN = false;
    bf16 *FT, *QL, *KVK, *GATES; const float* b_gate; int pn_off, rq;
    __device__ __forceinline__ void operator()(AccRef acc, const pg8::Unit& u0, int wr_, int wc_, int fr_, int fq_) const {
        EPI_IDS();
        pg8::Unit u; u.pm = u0.pm; u.pn = u0.pn + pn_off;
        const int row0 = u.pm * 256 + wr * 64 + fr, cw = wc * 32 + 8 * fq;
        if (u.pn < 2) {
#pragma unroll
            for (int ai = 0; ai < 2; ++ai)
#pragma unroll
                for (int m = 0; m < 4; ++m) { const int row = row0 + ai * 128 + m * 16; const int b = row >> 12, n = row & 4095;
#pragma unroll
                    for (int bj = 0; bj < 2; ++bj) { const int c0 = u.pn * 256 + bj * 128 + cw; bf16* p = FT + (((size_t)(b * 512 + c0)) << 12) + n;
                        store_t8(p, 4096, pk8(acc[ai][bj][m][0], acc[ai][bj][m][1]), fr & 1); } }
        } else if (u.pn < 4) {
            bf16* base = (u.pn == 2) ? QL : KVK;
#pragma unroll
            for (int ai = 0; ai < 2; ++ai) { if (rq >= 0 && ai * 2 + wr != rq) continue;
#pragma unroll
                for (int m = 0; m < 4; ++m) { const int row = row0 + ai * 128 + m * 16;
#pragma unroll
                    for (int bj = 0; bj < 2; ++bj) *(v4u*)(base + (size_t)row * 256 + bj * 128 + cw) = pk8(acc[ai][bj][m][0], acc[ai][bj][m][1]); } }
        } else {
            const int gc = (u.pn - 4) * 256 + cw;
#pragma unroll
            for (int bj = 0; bj < 2; ++bj) { const f32x4 b0 = *(const f32x4*)(b_gate + gc + bj * 128), b1 = *(const f32x4*)(b_gate + gc + bj * 128 + 4);
#pragma unroll
                for (int ai = 0; ai < 2; ++ai)
#pragma unroll
                    for (int m = 0; m < 4; ++m) { const int row = row0 + ai * 128 + m * 16; f32x4 v0 = acc[ai][bj][m][0] + b0, v1 = acc[ai][bj][m][1] + b1;
#pragma unroll
                        for (int e = 0; e < 4; ++e) { v0[e] = sigmoidf_fast(v0[e]); v1[e] = sigmoidf_fast(v1[e]); }
                        *(v4u*)(GATES + (size_t)row * 2048 + gc + bj * 128) = pk8(v0, v1); } }
        }
    }
};
template <int ACT  > struct EpiStore {
    static constexpr bool PERM = true, AFTER_DRAIN = false;
    bf16* O; int ldc;
    __device__ __forceinline__ void operator()(AccRef acc, const pg8::Unit& u, int wr_, int wc_, int fr_, int fq_) const {
        EPI_IDS();
        const int row0 = u.pm * 256 + wr * 64 + fr, c0 = u.pn * 256 + wc * 32 + 8 * fq;
#pragma unroll
        for (int ai = 0; ai < 2; ++ai)
#pragma unroll
            for (int m = 0; m < 4; ++m) { bf16* rp = O + (size_t)(row0 + ai * 128 + m * 16) * ldc + c0;
#pragma unroll
                for (int bj = 0; bj < 2; ++bj) { f32x4 v0 = acc[ai][bj][m][0], v1 = acc[ai][bj][m][1];
                    if (ACT == 1) {
#pragma unroll
                        for (int e = 0; e < 4; ++e) { const float a = fmaxf(v0[e], 0.f), b = fmaxf(v1[e], 0.f); v0[e] = a * a; v1[e] = b * b; } }
                    *(v4u*)(rp + bj * 128) = pk8(v0, v1); } }
    }
};
struct EpiKvUp {
    static constexpr bool PERM = true, AFTER_DRAIN = false;
    const bf16* KVK; bf16 *KF, *VT;
    __device__ __forceinline__ void operator()(AccRef acc, const pg8::Unit& u, int wr_, int wc_, int fr_, int fq_) const {
        EPI_IDS();
        const int row0 = u.pm * 256 + wr * 64 + fr;
#pragma unroll
        for (int ai = 0; ai < 2; ++ai) {
            v4u kw[4][4];
#pragma unroll
            for (int m = 0; m < 4; ++m) { const v4u* kp = (const v4u*)(KVK + (size_t)(row0 + ai * 128 + m * 16) * 256 + fq * 32);
#pragma unroll
                for (int i = 0; i < 4; ++i) kw[m][i] = kp[i]; }
            float rs[4];
#pragma unroll
            for (int m = 0; m < 4; ++m) { float s = 0.f;
#pragma unroll
                for (int i = 0; i < 4; ++i) { const v4u w = kw[m][i];
                    s += bflo(w.x) * bflo(w.x) + bfhi(w.x) * bfhi(w.x) + bflo(w.y) * bflo(w.y) + bfhi(w.y) * bfhi(w.y)
                       + bflo(w.z) * bflo(w.z) + bfhi(w.z) * bfhi(w.z) + bflo(w.w) * bflo(w.w) + bfhi(w.w) * bfhi(w.w); }
                s += __shfl_xor(s, 16); s += __shfl_xor(s, 32);
                rs[m] = __builtin_amdgcn_rsqf(s * (1.0f / 128.0f) + EPS); }
#pragma unroll
            for (int m = 0; m < 4; ++m) { const int row = row0 + ai * 128 + m * 16;
                int b, key; row_to_bkey(row, b, key);
#pragma unroll
                for (int bj = 0; bj < 2; ++bj) { const int head = 2 * u.pn + bj; const f32x4 v0 = acc[ai][bj][m][0] * rs[m], v1 = acc[ai][bj][m][1] * rs[m]; const v4u w = pk8(v0, v1);
                    if (wc < 2) { *(v4u*)(KF + ((size_t)((b * NH + head) * NKEY + key)) * DQK + wc * 32 + 8 * fq) = w; }
                    else { bf16* p = VT + ((size_t)((b * NH + head) * DV + (wc - 2) * 32 + 8 * fq)) * NKEY + key; store_t8(p, NKEY, w, fr & 1); } } }
            asm volatile("" ::: "memory"); }
    }
};
struct EpiDft {
    static constexpr bool PERM = true, AFTER_DRAIN = false;
    bf16* PM; const bf16* FT; int b;
    __device__ __forceinline__ void operator()(AccRef acc, const pg8::Unit& u, int wr_, int wc_, int fr_, int fq_) const {
        EPI_IDS();
        const int row0 = u.pm * 256 + wr * 64 + fr; const int s = u.pm >> 3;
        float t[2][8];
#pragma unroll
        for (int bj = 0; bj < 2; ++bj)
#pragma unroll
            for (int e = 0; e < 8; ++e) { const int col = u.pn * 256 + bj * 128 + wc * 32 + 8 * fq + e; t[bj][e] = s ? 0.f : bf2f(FT[((size_t)(b * 512 + col) << 12) + 2048]); }
#pragma unroll
        for (int ai = 0; ai < 2; ++ai)
#pragma unroll
            for (int m = 0; m < 4; ++m) { const int row = row0 + ai * 128 + m * 16; const int np = row & 2047; const float sg2 = (np & 1) ? -1.f : 1.f;
#pragma unroll
                for (int bj = 0; bj < 2; ++bj) { const int dc = (2 * u.pn + bj) * 256 + s * 128 + wc * 32 + 8 * fq;
                    f32x4 v0 = acc[ai][bj][m][0], v1 = acc[ai][bj][m][1];
#pragma unroll
                    for (int e = 0; e < 4; ++e) { v0[e] += sg2 * t[bj][e]; v1[e] += sg2 * t[bj][4 + e]; }
                    *(v4u*)(PM + ((size_t)(b * SEQ + np)) * 1024 + dc) = pk8(v0, v1);
                    if (np != 0) { const float sg = s ? -1.f : 1.f; *(v4u*)(PM + ((size_t)(b * SEQ + SEQ - np)) * 1024 + dc) = pk8(v0 * sg, v1 * sg); } } }
    }
};
struct EpiMerge1 {
    static constexpr bool PERM = true, AFTER_DRAIN = false;
    const bf16* GATES; bf16* Y;
    __device__ __forceinline__ void operator()(AccRef acc, const pg8::Unit& u, int wr_, int wc_, int fr_, int fq_) const {
        EPI_IDS();
        const int row0 = u.pm * 256 + wr * 64 + fr, c0 = u.pn * 256 + wc * 32 + 8 * fq;
#pragma unroll
        for (int ai = 0; ai < 2; ++ai)
#pragma unroll
            for (int m = 0; m < 4; ++m) { const int row = row0 + ai * 128 + m * 16;
#pragma unroll
                for (int bj = 0; bj < 2; ++bj) { const v4u g = *(const v4u*)(GATES + (size_t)row * 2048 + c0 + bj * 128);
                    f32x4 v0 = acc[ai][bj][m][0], v1 = acc[ai][bj][m][1];
                    v0[0] *= bflo(g.x); v0[1] *= bfhi(g.x); v0[2] *= bflo(g.y); v0[3] *= bfhi(g.y); v1[0] *= bflo(g.z); v1[1] *= bfhi(g.z); v1[2] *= bflo(g.w); v1[3] *= bfhi(g.w);
                    *(v4u*)(Y + (size_t)row * 1024 + c0 + bj * 128) = pk8(v0, v1); }
                if (m & 1) asm volatile("" ::: "memory"); }
    }
};
struct EpiMerge2 {
    static constexpr bool PERM = true, AFTER_DRAIN = false;
    const bf16* GATES; bf16* Y;
    __device__ __forceinline__ void operator()(AccRef acc, const pg8::Unit& u, int wr_, int wc_, int fr_, int fq_) const {
        EPI_IDS();
        const int row0 = u.pm * 256 + wr * 64 + fr, c0 = u.pn * 256 + wc * 32 + 8 * fq;
#pragma unroll
        for (int ai = 0; ai < 2; ++ai)
#pragma unroll
            for (int m = 0; m < 4; ++m) { const int row = row0 + ai * 128 + m * 16;
#pragma unroll
                for (int bj = 0; bj < 2; ++bj) { const v4u g = *(const v4u*)(GATES + (size_t)row * 2048 + 1024 + c0 + bj * 128);
                    bf16* yp = Y + (size_t)row * 1024 + c0 + bj * 128; const v4u t = *(const v4u*)yp;
                    f32x4 v0 = acc[ai][bj][m][0], v1 = acc[ai][bj][m][1];
                    v0[0] = v0[0] * bflo(g.x) + bflo(t.x); v0[1] = v0[1] * bfhi(g.x) + bfhi(t.x); v0[2] = v0[2] * bflo(g.y) + bflo(t.y); v0[3] = v0[3] * bfhi(g.y) + bfhi(t.y);
                    v1[0] = v1[0] * bflo(g.z) + bflo(t.z); v1[1] = v1[1] * bfhi(g.z) + bfhi(t.z); v1[2] = v1[2] * bflo(g.w) + bflo(t.w); v1[3] = v1[3] * bfhi(g.w) + bfhi(t.w);
                    *(v4u*)yp = pk8(v0, v1); }
                if (m & 1) asm volatile("" ::: "memory"); }
    }
};
struct EpiResid {
    static constexpr bool PERM = true, AFTER_DRAIN = false;
    const float* base; float* out; const float* gate;
    __device__ __forceinline__ void operator()(AccRef acc, const pg8::Unit& u, int wr_, int wc_, int fr_, int fq_) const {
        EPI_IDS();
        const int row0 = u.pm * 256 + wr * 64 + fr, c0 = u.pn * 256 + wc * 32 + 8 * fq; const int b = (u.pm * 256) >> 12;
        f32x4 gv[2][2];
#pragma unroll
        for (int bj = 0; bj < 2; ++bj)
#pragma unroll
            for (int n = 0; n < 2; ++n) gv[bj][n] = *(const f32x4*)(gate + (size_t)b * 6144 + c0 + bj * 128 + n * 4);
#pragma unroll
        for (int ai = 0; ai < 2; ++ai)
#pragma unroll
            for (int m = 0; m < 4; ++m) { const size_t off = (size_t)(row0 + ai * 128 + m * 16) * 1024 + c0;
#pragma unroll
                for (int bj = 0; bj < 2; ++bj)
#pragma unroll
                    for (int n = 0; n < 2; ++n) { const f32x4 bs = *(const f32x4*)(base + off + bj * 128 + n * 4);
                        *(f32x4*)(out + off + bj * 128 + n * 4) = bs + gv[bj][n] * acc[ai][bj][m][n]; }
                if (m & 1) asm volatile("" ::: "memory"); }
    }
};

struct EpiResidX {
    static constexpr bool PERM = true, AFTER_DRAIN = false;
    const float* base; float* out; const float* MODp; const float* n2g; bf16* XS; float* RS2;
    __device__ __forceinline__ void operator()(AccRef acc, const pg8::Unit& u, int wr_, int wc_, int fr_, int fq_) const {
        EPI_IDS();
        const int row0 = u.pm * 256 + wr * 64 + fr, c0 = u.pn * 256 + wc * 32 + 8 * fq; const int b = (u.pm * 256) >> 12;
        f32x4 gv[2][2], gs[2][2];
#pragma unroll
        for (int bj = 0; bj < 2; ++bj)
#pragma unroll
            for (int n = 0; n < 2; ++n) { const int c = c0 + bj * 128 + n * 4; gv[bj][n] = *(const f32x4*)(MODp + (size_t)b * 6144 + 2048 + c);
                gs[bj][n] = *(const f32x4*)(n2g + c) * (*(const f32x4*)(MODp + (size_t)b * 6144 + 4096 + c) + 1.0f); }
#pragma unroll
        for (int ai = 0; ai < 2; ++ai)
#pragma unroll
            for (int m = 0; m < 4; ++m) { const int row = row0 + ai * 128 + m * 16; const size_t off = (size_t)row * 1024 + c0; float ss = 0.f;
#pragma unroll
                for (int bj = 0; bj < 2; ++bj) { const f32x4 b0 = __builtin_nontemporal_load((const f32x4*)(base + off + bj * 128)), b1 = __builtin_nontemporal_load((const f32x4*)(base + off + bj * 128 + 4));
                    const f32x4 x0 = b0 + gv[bj][0] * acc[ai][bj][m][0], x1 = b1 + gv[bj][1] * acc[ai][bj][m][1];
                    *(f32x4*)(out + off + bj * 128) = x0; *(f32x4*)(out + off + bj * 128 + 4) = x1;
                    ss += ((x0[0] * x0[0] + x0[1] * x0[1]) + (x0[2] * x0[2] + x0[3] * x0[3])) + ((x1[0] * x1[0] + x1[1] * x1[1]) + (x1[2] * x1[2] + x1[3] * x1[3]));
                    *(v4u*)(XS + off + bj * 128) = pk8(x0 * gs[bj][0], x1 * gs[bj][1]); }
                ss += __shfl_xor(ss, 16); ss += __shfl_xor(ss, 32);
                if (fq == 0) atomicAdd(RS2 + row, ss);
                if (m & 1) asm volatile("" ::: "memory"); }
    }
};
struct EpiUp {
    static constexpr bool PERM = true, AFTER_DRAIN = false;
    bf16* O; const float* RS2; const float* BIAS2;
    __device__ __forceinline__ void operator()(AccRef acc, const pg8::Unit& u, int wr_, int wc_, int fr_, int fq_) const {
        EPI_IDS();
        const int row0 = u.pm * 256 + wr * 64 + fr, c0 = u.pn * 256 + wc * 32 + 8 * fq; const int b = (u.pm * 256) >> 12;
        f32x4 bv[2][2];
#pragma unroll
        for (int bj = 0; bj < 2; ++bj) { bv[bj][0] = *(const f32x4*)(BIAS2 + (size_t)b * 4096 + c0 + bj * 128); bv[bj][1] = *(const f32x4*)(BIAS2 + (size_t)b * 4096 + c0 + bj * 128 + 4); }
#pragma unroll
        for (int ai = 0; ai < 2; ++ai)
#pragma unroll
            for (int m = 0; m < 4; ++m) { const int row = row0 + ai * 128 + m * 16; const float rs = __builtin_amdgcn_rsqf(RS2[row] * (1.0f / 1024.0f) + EPS);
                bf16* rp = O + (size_t)row * DFF + c0;
#pragma unroll
                for (int bj = 0; bj < 2; ++bj) { f32x4 v0 = acc[ai][bj][m][0] * rs + bv[bj][0], v1 = acc[ai][bj][m][1] * rs + bv[bj][1];
#pragma unroll
                    for (int e = 0; e < 4; ++e) { const float a = fmaxf(v0[e], 0.f), c = fmaxf(v1[e], 0.f); v0[e] = a * a; v1[e] = c * c; }
                    *(v4u*)(rp + bj * 128) = pk8(v0, v1); } }
    }
};


struct Args;
struct Frame {
    LAS unsigned char* lds;
    volatile LAS unsigned* MISC;
    gu32* ctl;
    int tid, lane, wave, vcu, G, bx;
    unsigned char* ws;
    const __attribute__((address_space(4))) struct Args* ap;
};
struct Args { const float* in[21]; float* out; unsigned char* ws; int ph_lo, ph_hi, li, pad; };

__device__ __forceinline__ void transpose_item(const float* W, int K, int N, bf16* WT, int ldk, int drow, const float* rs, LAS float* scr, int kb, int nb, int lane) {
    const int k0 = 64 * kb, n0 = 32 * nb;
    float tv[32];
#pragma unroll
    for (int i = 0; i < 32; ++i) { const int kk = 2 * i + (lane >> 5); tv[i] = __builtin_nontemporal_load(W + (size_t)(k0 + kk) * N + n0 + (lane & 31)); }
#pragma unroll
    for (int i = 0; i < 32; ++i) { const int kk = 2 * i + (lane >> 5); scr[kk * 33 + (lane & 31)] = tv[i]; }
    LDS_WAIT(); asm volatile("" ::: "memory");
    const int c = lane & 7;
    float sc[8];
#pragma unroll
    for (int e = 0; e < 8; ++e) sc[e] = rs ? rs[k0 + 8 * c + e] : 1.0f;
#pragma unroll
    for (int j = 0; j < 4; ++j) { const int n = (lane >> 3) + 8 * j; const LAS float* s = scr + (8 * c) * 33 + n;
        v4u o; o.x = pk2(s[0 * 33] * sc[0], s[1 * 33] * sc[1]); o.y = pk2(s[2 * 33] * sc[2], s[3 * 33] * sc[3]); o.z = pk2(s[4 * 33] * sc[4], s[5 * 33] * sc[5]); o.w = pk2(s[6 * 33] * sc[6], s[7 * 33] * sc[7]);
        *(GAS v4u*)(WT + (size_t)(drow + n0 + n) * ldk + k0 + 8 * c) = o; }
    LDS_WAIT(); asm volatile("" ::: "memory");
}
__device__ __forceinline__ float silu_f(float x) { return x / (1.0f + __expf(-x)); }
__device__ __forceinline__ void ada_block(Frame& F, int cg) {
    const float* c = F.ap->in[1]; const float* c_ctx = F.ap->in[3]; const float* ada_w = F.ap->in[4]; const float* ada_b = F.ap->in[5];
    float* MOD = (float*)(F.ws + WS_MOD);
    const int lane = F.lane, col = cg * 64 + lane, k0 = F.wave * 128;
    float a[5];
#pragma unroll
    for (int r = 0; r < 5; ++r) a[r] = 0.f;
#pragma unroll
    for (int half = 0; half < 2; ++half) {
        float s[5];
#pragma unroll
        for (int r = 0; r < 4; ++r) s[r] = silu_f(c[r * 1024 + k0 + half * 64 + lane]);
        s[4] = silu_f(c_ctx[k0 + half * 64 + lane]);
        const float* wp = ada_w + (size_t)(k0 + half * 64) * 6144 + col;
        float wv[64];
#pragma unroll
        for (int kk = 0; kk < 64; ++kk) wv[kk] = __builtin_nontemporal_load(wp + (size_t)kk * 6144);
#pragma unroll
        for (int kk = 0; kk < 64; ++kk) {
#pragma unroll
            for (int r = 0; r < 5; ++r) a[r] += __shfl(s[r], kk) * wv[kk]; }
    }
    LAS float* part = (LAS float*)(F.lds + RING_OFF + 8 * 16384 - 16384);
    part = (LAS float*)(F.lds + TAB_OFF + 1024);
#pragma unroll
    for (int r = 0; r < 5; ++r) part[(F.wave * 5 + r) * 64 + lane] = a[r];
    __syncthreads();
    if (F.tid < 320) { const int r = F.tid >> 6, l = F.tid & 63; float v = ada_b[cg * 64 + l];
#pragma unroll
        for (int w = 0; w < 8; ++w) v += part[(w * 5 + r) * 64 + l];
        MOD[(size_t)r * 6144 + cg * 64 + l] = v; }
}
__device__ __forceinline__ void wf_item(const float* wf, bf16* WFT, const LAS float* tab, int item, int lane) {
    const int cb = item % 9, jb = (item / 9) & 15, g = item / 144; const int j = jb * 64 + lane, cbase = cb * 8;
    const float* wp = wf + (size_t)(g * 128) * 1024 + j;
    const float w0 = wp[0], w64 = wp[(size_t)64 * 1024];
    float ac[8], as[8];
#pragma unroll
    for (int i = 0; i < 8; ++i) { ac[i] = w0 + (((cbase + i) & 1) ? -w64 : w64); as[i] = 0.f; }
    for (int c0 = 1; c0 < 64; c0 += 21) { float fe[21], fo[21];
#pragma unroll
        for (int u = 0; u < 21; ++u) { const float a = wp[(size_t)(c0 + u) * 1024], b = wp[(size_t)(128 - c0 - u) * 1024]; fe[u] = a + b; fo[u] = a - b; }
#pragma unroll
        for (int u = 0; u < 21; ++u) { const int cp = c0 + u;
#pragma unroll
            for (int i = 0; i < 8; ++i) { const int idx = ((cbase + i) * cp) & 127; ac[i] += tab[idx] * fe[u]; as[i] += tab[128 + idx] * fo[u]; } } }
    bf16* op = WFT + (size_t)j * 1024 + g * 256;
    unsigned short hc[8], hs[8];
#pragma unroll
    for (int i = 0; i < 8; i += 2) { const unsigned a = pk2(ac[i] * DFT_NORM, ac[i + 1] * DFT_NORM), b = pk2(-as[i] * DFT_NORM, -as[i + 1] * DFT_NORM);
        hc[i] = (unsigned short)(a & 0xffffu); hc[i + 1] = (unsigned short)(a >> 16); hs[i] = (unsigned short)(b & 0xffffu); hs[i + 1] = (unsigned short)(b >> 16); }
    if (cb < 8) {
        v4u o; o.x = hc[0] | ((unsigned)hc[1] << 16); o.y = hc[2] | ((unsigned)hc[3] << 16); o.z = hc[4] | ((unsigned)hc[5] << 16); o.w = hc[6] | ((unsigned)hc[7] << 16);
        *(v4u*)(op + cbase) = o;
        o.x = hs[0] | ((unsigned)hs[1] << 16); o.y = hs[2] | ((unsigned)hs[3] << 16); o.z = hs[4] | ((unsigned)hs[5] << 16); o.w = hs[6] | ((unsigned)hs[7] << 16);
        *(v4u*)(op + 128 + cbase) = o;
#pragma unroll
        for (int i = 0; i < 8; ++i) { const int c = cbase + i; if (c != 0) { op[128 - c] = hc[i]; op[128 + 128 - c] = (unsigned short)(hs[i] ^ 0x8000u); } }
    } else { op[64] = hc[0]; op[128 + 64] = hs[0]; }
}
__device__ __forceinline__ void dft_item(bf16* DFT, int item, int lane) {
    const int chunk = item * 64 + lane; const int m = chunk >> 8, n0 = (chunk & 255) * 8; const int s = m >> 11, np = m & 2047;
    float v[8];
#pragma unroll
    for (int e = 0; e < 8; ++e) { const int idx = (np * (n0 + e)) & 4095; const float t = (float)idx * (1.0f / 4096.0f); v[e] = s ? __builtin_amdgcn_sinf(t) : __builtin_amdgcn_cosf(t); }
    v4u o; o.x = pk2(v[0], v[1]); o.y = pk2(v[2], v[3]); o.z = pk2(v[4], v[5]); o.w = pk2(v[6], v[7]);
    *(v4u*)(DFT + (size_t)m * 2048 + n0) = o;
}
__device__ __forceinline__ void fold_item(const bf16* FT, bf16* FE, bf16* FO, bf16* PM, LAS bf16* scr, int item, int lane) {
    const v4u* src = (const v4u*)(FT + (size_t)item * 4096);
#pragma unroll
    for (int i = 0; i < 8; ++i) ((LAS v4u*)scr)[lane + 64 * i] = src[lane + 64 * i];
    LDS_WAIT(); asm volatile("" ::: "memory");
    float alt = 0.f;
#pragma unroll
    for (int j = 0; j < 4; ++j) { const int n0 = (j * 64 + lane) * 8; float fe[8], fo[8];
#pragma unroll
        for (int e = 0; e < 8; ++e) { const int n = n0 + e; const float a = bf2f(scr[n]); const float bm = bf2f(scr[(4096 - n) & 4095]); fe[e] = (n == 0) ? a : a + bm; fo[e] = (n == 0) ? 0.f : a - bm;
            alt += (e & 1) ? -fe[e] : fe[e]; }
        v4u o; o.x = pk2(fe[0], fe[1]); o.y = pk2(fe[2], fe[3]); o.z = pk2(fe[4], fe[5]); o.w = pk2(fe[6], fe[7]);
        *(v4u*)(FE + (size_t)item * 2048 + n0) = o;
        o.x = pk2(fo[0], fo[1]); o.y = pk2(fo[2], fo[3]); o.z = pk2(fo[4], fo[5]); o.w = pk2(fo[6], fo[7]);
        *(v4u*)(FO + (size_t)item * 2048 + n0) = o; }
    alt = wave_sum(alt);
    if (lane == 0) { alt += bf2f(scr[2048]);
        const int b = item >> 9, col = item & 511; bf16* o = PM + ((size_t)(b * SEQ + 2048)) * 1024 + (col >> 7) * 256 + (col & 127);
        o[0] = (bf16)(pk2(alt, 0.f) & 0xffffu); o[128] = 0; }
    LDS_WAIT(); asm volatile("" ::: "memory");
}

__device__ __forceinline__ void p0_prep(Frame& F) {
    LAS float* tab = (LAS float*)(F.lds + TAB_OFF);
    if (F.tid < 128) { const float t = (float)F.tid * (1.0f / 128.0f); tab[F.tid] = __builtin_amdgcn_cosf(t); tab[128 + F.tid] = __builtin_amdgcn_sinf(t); }
    __syncthreads();
    LAS float* scr = (LAS float*)(F.lds + RING_OFF + F.wave * 16384);
    const int gw = F.vcu * 8 + F.wave, NGW = F.G * 8;
    unsigned char* ws = F.ws;
    if (F.bx < 96) ada_block(F, F.bx);
    constexpr int I_WIN = 16 * 93, I_WQB = 4 * 24, I_WKVB = 2 * 32, I_Z1 = 192, I_Z2 = 256;
    constexpr int NIT = I_WIN + I_WQB + I_WKVB + I_Z1 + I_Z2;
    for (int it = gw; it < NIT; it += NGW) {
        int r = it;
        if (r < I_WIN) { const int kb = r / 93, nb = r % 93; const int n0 = nb * 32; const int drow = (n0 < 928) ? 0 : 96;
            transpose_item(F.ap->in[8], 1024, DIN, (bf16*)(ws + WS_WIN), 1024, drow, nullptr, scr, kb, nb, F.lane); continue; } r -= I_WIN;
        if (r < I_WQB) { transpose_item(F.ap->in[12], 256, 768, (bf16*)(ws + WS_WQB), 256, 0, F.ap->in[11], scr, r / 24, r % 24, F.lane); continue; } r -= I_WQB;
        if (r < I_WKVB) { transpose_item(F.ap->in[14], 128, 1024, (bf16*)(ws + WS_WKVB), 256, 0, F.ap->in[13], scr, r / 32, r % 32, F.lane); continue; } r -= I_WKVB;
        if (r < I_Z1) { const int ch = r * 64 + F.lane; *(v4u*)(ws + WS_WIN + (size_t)928 * 2048 + (size_t)ch * 16) = (v4u){0u, 0u, 0u, 0u}; continue; } r -= I_Z1;
        { const int ch = r * 64 + F.lane; *(v4u*)(ws + WS_WKVB + (size_t)(ch >> 4) * 512 + 256 + (ch & 15) * 16) = (v4u){0u, 0u, 0u, 0u}; }
    }
}
__device__ __forceinline__ void bias2_item(const float* MODp, const float* w_up, float* BIAS2, int item, int lane) {
    const int cg = item & 63, kc = item >> 6, col = cg * 64 + lane, k0 = kc * 64;
    float s[4], a[4];
#pragma unroll
    for (int r = 0; r < 4; ++r) { s[r] = MODp[(size_t)r * 6144 + 3072 + k0 + lane]; a[r] = 0.f; }
    const float* wp = w_up + (size_t)k0 * 4096 + col;
    float wv[64];
#pragma unroll
    for (int kk = 0; kk < 64; ++kk) wv[kk] = wp[(size_t)kk * 4096];
#pragma unroll
    for (int kk = 0; kk < 64; ++kk) {
#pragma unroll
        for (int r = 0; r < 4; ++r) a[r] += __shfl(s[r], kk) * wv[kk]; }
#pragma unroll
    for (int r = 0; r < 4; ++r) atomicAdd(BIAS2 + (size_t)r * 4096 + col, a[r]);
}
__device__ __forceinline__ void prep_late(Frame& F, const int gw, const int NGW) {
    LAS float* tab = (LAS float*)(F.lds + TAB_OFF);
    LAS float* scr = (LAS float*)(F.lds + RING_OFF + F.wave * 16384);
    unsigned char* ws = F.ws;
    constexpr int I_WMO = 8 * 32, I_WOUT = 16 * 32, I_WF = 576, I_B2 = 1024, I_UP = 16 * 128, I_DFT = 16384;
    constexpr int NIT = I_WMO + I_WOUT + I_WF + I_B2 + I_UP + I_DFT;
    for (int it = gw; it < NIT; it += NGW) {
        int r = it;
        if (r < I_WMO) { transpose_item(F.ap->in[17], 512, 1024, (bf16*)(ws + WS_WMO), 512, 0, nullptr, scr, r / 32, r % 32, F.lane); continue; } r -= I_WMO;
        if (r < I_WOUT) { transpose_item(F.ap->in[18], 1024, 1024, (bf16*)(ws + WS_WOUT), 1024, 0, nullptr, scr, r / 32, r % 32, F.lane); continue; } r -= I_WOUT;
        if (r < I_WF) { wf_item(F.ap->in[10], (bf16*)(ws + WS_WF), tab, r, F.lane); continue; } r -= I_WF;
        if (r < I_B2) { bias2_item((const float*)(ws + WS_MOD), F.ap->in[19], (float*)(ws + WS_BIAS2), r, F.lane); continue; } r -= I_B2;
        if (r < I_UP) { transpose_item(F.ap->in[19], 1024, 4096, (bf16*)(ws + WS_WUP), 1024, 0, nullptr, scr, r / 128, r % 128, F.lane); continue; } r -= I_UP;
        dft_item((bf16*)(ws + WS_DFT), r, F.lane);
    }
}
__device__ __forceinline__ void p1_mod(Frame& F) {
    const float* PART = (const float*)(F.ws + WS_PART); float* MOD = (float*)(F.ws + WS_MOD);
    for (int o = F.vcu * 512 + F.tid; o < 5 * 6144; o += F.G * 512) { const int j = o % 6144, r = o / 6144; float v = F.ap->in[5][j];
#pragma unroll
        for (int kc = 0; kc < 16; ++kc) v += PART[(size_t)(kc * 5 + r) * 6144 + j];
        MOD[o] = v; }
}
__device__ __forceinline__ void norm_row_load(const float* xrow, int lane, f32x4 (&v)[4]) {
    const f32x4* xr = (const f32x4*)xrow + lane;
#pragma unroll
    for (int j = 0; j < 4; ++j) v[j] = __builtin_nontemporal_load(xr + 64 * j);
}
__device__ __forceinline__ void norm_row_finish(const f32x4 (&v)[4], const float* g, const float* sh, const float* sc, bf16* orow, int lane) {
    float s = 0.f;
#pragma unroll
    for (int j = 0; j < 4; ++j) s += (v[j].x * v[j].x + v[j].y * v[j].y) + (v[j].z * v[j].z + v[j].w * v[j].w);
    const float rstd = __builtin_amdgcn_rsqf(wave_sum(s) * (1.0f / 1024.0f) + EPS);
    unsigned long long* o8 = (unsigned long long*)orow + lane;
#pragma unroll
    for (int j = 0; j < 4; ++j) { const f32x4 gg = ((const f32x4*)g)[64 * j + lane], hh = ((const f32x4*)sh)[64 * j + lane], cc = ((const f32x4*)sc)[64 * j + lane];
        const f32x4 y = (v[j] * rstd * gg) * (cc + 1.0f) + hh;
        o8[64 * j] = (unsigned long long)pk2(y.x, y.y) | ((unsigned long long)pk2(y.z, y.w) << 32); }
}
__device__ __forceinline__ void norm_vecs(const float* g, const float* sh, const float* sc, int lane, f32x4 (&A)[4], f32x4 (&B)[4]) {
#pragma unroll
    for (int j = 0; j < 4; ++j) { const f32x4 gg = ((const f32x4*)g)[64 * j + lane], cc = ((const f32x4*)sc)[64 * j + lane]; A[j] = gg * (cc + 1.0f); B[j] = ((const f32x4*)sh)[64 * j + lane]; }
}
__device__ __forceinline__ void norm_row_finish_v(const f32x4 (&v)[4], const f32x4 (&A)[4], const f32x4 (&B)[4], bf16* orow, int lane) {
    float s = 0.f;
#pragma unroll
    for (int j = 0; j < 4; ++j) s += (v[j].x * v[j].x + v[j].y * v[j].y) + (v[j].z * v[j].z + v[j].w * v[j].w);
    const float rstd = __builtin_amdgcn_rsqf(wave_sum(s) * (1.0f / 1024.0f) + EPS);
    unsigned long long* o8 = (unsigned long long*)orow + lane;
#pragma unroll
    for (int j = 0; j < 4; ++j) { const f32x4 y = (v[j] * rstd) * A[j] + B[j];
        o8[64 * j] = (unsigned long long)pk2(y.x, y.y) | ((unsigned long long)pk2(y.z, y.w) << 32); }
}
__device__ __forceinline__ void norm_mod_row(const float* xrow, const float* g, const float* sh, const float* sc, bf16* orow, int lane) {
    f32x4 v[4]; norm_row_load(xrow, lane, v); norm_row_finish(v, g, sh, sc, orow, lane);
}
__device__ __forceinline__ void wdown_copy(Frame& F) {
    LAS float* scr = (LAS float*)(F.lds + RING_OFF + F.wave * 16384);
    const int gw = F.vcu * 8 + F.wave, NGW = F.G * 8;
    for (int it = gw; it < 64 * 32; it += NGW) transpose_item(F.ap->in[20], 4096, 1024, (bf16*)(F.ws + WS_WDOWN), 4096, 0, nullptr, scr, it / 32, it % 32, F.lane);
}

__device__ __forceinline__ void rope_cs(int n, int l8, float& cr, float& sr, float& cc, float& sc) {
    const float fr8[8] = {1.0f, 0.31622776601683794f, 0.1f, 0.031622776601683794f, 0.01f, 0.0031622776601683794f, 0.001f, 0.00031622776601683794f};
    float f = fr8[0];
#pragma unroll
    for (int i = 1; i < 8; ++i) f = (l8 == i) ? fr8[i] : f;
    const float INV2PI = 0.15915494309189535f;
    const float ar = (float)(n >> 6) * f * INV2PI, ac = (float)(n & 63) * f * INV2PI;
    const float arf = ar - floorf(ar), acf = ac - floorf(ac);
    cr = __builtin_amdgcn_cosf(arf); sr = __builtin_amdgcn_sinf(arf); cc = __builtin_amdgcn_cosf(acf); sc = __builtin_amdgcn_sinf(acf);
}
__device__ __forceinline__ float sumsq8(const v4u w) {
    return bflo(w.x) * bflo(w.x) + bfhi(w.x) * bfhi(w.x) + bflo(w.y) * bflo(w.y) + bfhi(w.y) * bfhi(w.y)
         + bflo(w.z) * bflo(w.z) + bfhi(w.z) * bfhi(w.z) + bflo(w.w) * bflo(w.w) + bfhi(w.w) * bfhi(w.w);
}
struct FinRow { v4u kv; float a1, a2, b1, b2; v4u qv; float qa1, qa2, qb1, qb2; float sq; };
__device__ __forceinline__ void finalize_load(Frame& F, int row, FinRow& R) {
    const int lane = F.lane, h = lane >> 3, l8 = lane & 7;
    const bf16* KF = (const bf16*)(F.ws + WS_KF); const bf16* KVK = (const bf16*)(F.ws + WS_KVK); const bf16* QR = (const bf16*)(F.ws + WS_QR); const bf16* QL = (const bf16*)(F.ws + WS_QL);
    int b, key; row_to_bkey(row, b, key);
    const bf16* kp = KF + ((size_t)((b * NH + h) * NKEY + key)) * DQK;
    R.kv = *(const v4u*)(kp + 8 * l8);
    const bf16* krp = KVK + (size_t)row * 256 + 128;
    R.a1 = bf2f(krp[l8]); R.a2 = bf2f(krp[8 + l8]); R.b1 = bf2f(krp[16 + l8]); R.b2 = bf2f(krp[24 + l8]);
    if (row < MT) {
        const v2u qw = *(const v2u*)(QL + (size_t)row * 256 + 4 * lane);
        R.sq = bflo(qw.x) * bflo(qw.x) + bfhi(qw.x) * bfhi(qw.x) + bflo(qw.y) * bflo(qw.y) + bfhi(qw.y) * bfhi(qw.y);
        const bf16* qp = QR + (size_t)row * 768 + h * DQK;
        R.qv = *(const v4u*)(qp + 8 * l8);
        R.qa1 = bf2f(qp[64 + l8]); R.qa2 = bf2f(qp[72 + l8]); R.qb1 = bf2f(qp[80 + l8]); R.qb2 = bf2f(qp[88 + l8]);
    }
}
__device__ __forceinline__ void finalize_store(Frame& F, int row, const FinRow& R) {
    const int lane = F.lane, h = lane >> 3, l8 = lane & 7;
    bf16* KF = (bf16*)(F.ws + WS_KF); bf16* QR = (bf16*)(F.ws + WS_QR);
    const float* q_gain = F.ap->in[15]; const float* k_gain = F.ap->in[16];
    int b, key; row_to_bkey(row, b, key);
    const bool lat = row < MT;
    float cr = 1.f, sr = 0.f, cc = 1.f, sc = 0.f;
    if (lat) rope_cs(key, l8, cr, sr, cc, sc);
    {
        bf16* kp = KF + ((size_t)((b * NH + h) * NKEY + key)) * DQK;
        const v4u kv = R.kv; float a1 = R.a1, a2 = R.a2, b1 = R.b1, b2 = R.b2;
        float ss = sumsq8(kv) + a1 * a1 + a2 * a2 + b1 * b1 + b2 * b2;
        ss += __shfl_xor(ss, 1); ss += __shfl_xor(ss, 2); ss += __shfl_xor(ss, 4);
        const float rk = __builtin_amdgcn_rsqf(ss * (1.0f / 96.0f) + EPS);
        const f32x4 g0 = *(const f32x4*)(k_gain + 8 * l8), g1 = *(const f32x4*)(k_gain + 8 * l8 + 4);
        v4u o; o.x = pk2(bflo(kv.x) * rk * g0[0], bfhi(kv.x) * rk * g0[1]); o.y = pk2(bflo(kv.y) * rk * g0[2], bfhi(kv.y) * rk * g0[3]);
        o.z = pk2(bflo(kv.z) * rk * g1[0], bfhi(kv.z) * rk * g1[1]); o.w = pk2(bflo(kv.w) * rk * g1[2], bfhi(kv.w) * rk * g1[3]);
        *(v4u*)(kp + 8 * l8) = o;
        a1 *= rk * k_gain[64 + l8]; a2 *= rk * k_gain[72 + l8]; b1 *= rk * k_gain[80 + l8]; b2 *= rk * k_gain[88 + l8];
        const float oa1 = a1 * cr - a2 * sr, oa2 = a2 * cr + a1 * sr, ob1 = b1 * cc - b2 * sc, ob2 = b2 * cc + b1 * sc;
        const unsigned w0 = pk2(oa1, oa2), w1 = pk2(ob1, ob2);
        kp[64 + l8] = (bf16)(w0 & 0xffffu); kp[72 + l8] = (bf16)(w0 >> 16); kp[80 + l8] = (bf16)(w1 & 0xffffu); kp[88 + l8] = (bf16)(w1 >> 16);
    }
    if (lat) {
        const float aq = __builtin_amdgcn_rsqf(wave_sum(R.sq) * (1.0f / 256.0f) + EPS);
        bf16* qp = QR + (size_t)row * 768 + h * DQK;
        const v4u qv = R.qv;
        float a1 = R.qa1 * aq, a2 = R.qa2 * aq, b1 = R.qb1 * aq, b2 = R.qb2 * aq;
        float ss = sumsq8(qv) * aq * aq + a1 * a1 + a2 * a2 + b1 * b1 + b2 * b2;
        ss += __shfl_xor(ss, 1); ss += __shfl_xor(ss, 2); ss += __shfl_xor(ss, 4);
        const float rq = __builtin_amdgcn_rsqf(ss * (1.0f / 96.0f) + EPS) * QSCALE; const float rqa = rq * aq;
        const f32x4 g0 = *(const f32x4*)(q_gain + 8 * l8), g1 = *(const f32x4*)(q_gain + 8 * l8 + 4);
        v4u o; o.x = pk2(bflo(qv.x) * rqa * g0[0], bfhi(qv.x) * rqa * g0[1]); o.y = pk2(bflo(qv.y) * rqa * g0[2], bfhi(qv.y) * rqa * g0[3]);
        o.z = pk2(bflo(qv.z) * rqa * g1[0], bfhi(qv.z) * rqa * g1[1]); o.w = pk2(bflo(qv.w) * rqa * g1[2], bfhi(qv.w) * rqa * g1[3]);
        a1 *= rq * q_gain[64 + l8]; a2 *= rq * q_gain[72 + l8]; b1 *= rq * q_gain[80 + l8]; b2 *= rq * q_gain[88 + l8];
        const float oa1 = a1 * cr - a2 * sr, oa2 = a2 * cr + a1 * sr, ob1 = b1 * cc - b2 * sc, ob2 = b2 * cc + b1 * sc;
        const unsigned w0 = pk2(oa1, oa2), w1 = pk2(ob1, ob2);
        *(v4u*)(qp + 8 * l8) = o;
        qp[64 + l8] = (bf16)(w0 & 0xffffu); qp[72 + l8] = (bf16)(w0 >> 16); qp[80 + l8] = (bf16)(w1 & 0xffffu); qp[88 + l8] = (bf16)(w1 >> 16);
    }
}
__device__ __forceinline__ void finalize_all(Frame& F) {
    const int gw = F.vcu * 8 + F.wave, NGW = F.G * 8;
    for (int base = gw; base < MA; base += 9 * NGW) {
        FinRow R[9];
#pragma unroll
        for (int i = 0; i < 9; ++i) { const int row = base + i * NGW; if (row < MA) finalize_load(F, row, R[i]); }
#pragma unroll
        for (int i = 0; i < 9; ++i) { const int row = base + i * NGW; if (row < MA) finalize_store(F, row, R[i]); }
    }
}
__device__ __forceinline__ void nyquist_item(Frame& F, int item) {
    const bf16* FT = (const bf16*)(F.ws + WS_FT); bf16* PM = (bf16*)(F.ws + WS_HX);
    const v4u* p = (const v4u*)(FT + (size_t)item * 4096) + F.lane; float s = 0.f;
#pragma unroll
    for (int i = 0; i < 8; ++i) { const v4u w = p[64 * i]; s += (bflo(w.x) - bfhi(w.x)) + (bflo(w.y) - bfhi(w.y)) + (bflo(w.z) - bfhi(w.z)) + (bflo(w.w) - bfhi(w.w)); }
    s = wave_sum(s);
    if (F.lane == 0) { const int b = item >> 9, col = item & 511; bf16* o = PM + ((size_t)(b * SEQ + 2048)) * 1024 + (col >> 7) * 256 + (col & 127);
        o[0] = (bf16)(pk2(s, 0.f) & 0xffffu); o[128] = 0; }
}


constexpr int AT_KROW = 208, AT_VROW = 144;
constexpr int AT_KT = 64 * AT_KROW, AT_VT = 64 * AT_VROW;
constexpr int AT_STAGE = 2 * AT_KT + 2 * AT_VT;
static_assert(2 * AT_STAGE <= RING_BYTES, "attention LDS");
__device__ __forceinline__ f32x16 mfma32(bf16x8 a, bf16x8 b, f32x16 c) { return __builtin_amdgcn_mfma_f32_32x32x16_bf16(a, b, c, 0, 0, 0); }

#ifdef DBG_NOEXP
#define AT_EXP(x) ((x) * 0.001f)
#else
#define AT_EXP(x) __builtin_amdgcn_exp2f(x)
#endif
constexpr int AT_KST = 2 * AT_KT, AT_VST = 2 * AT_VT, AT_VBASE = 2 * AT_KST;
__device__ __forceinline__ void attn_unit(Frame& F, int bh, int qb, const float negM) {
    const bf16* QR = (const bf16*)(F.ws + WS_QR); const bf16* KF = (const bf16*)(F.ws + WS_KF); const bf16* VT = (const bf16*)(F.ws + WS_VT); bf16* ATT = (bf16*)(F.ws + WS_ATT);
    const int tid = F.tid, lane = F.lane, wave = F.wave, qg = wave & 3, kh = wave >> 2, r = lane & 31, hh = lane >> 5;
    const int b = bh >> 3, h = bh & 7;
    const int tok = b * SEQ + qb * 128 + qg * 32 + r;
    bf16x8 qf[6];
    { const bf16* qp = QR + (size_t)tok * 768 + h * DQK + 8 * hh;
#pragma unroll
      for (int ks = 0; ks < 6; ++ks) qf[ks] = *(const bf16x8*)(qp + 16 * ks); }
    const unsigned char* kg = (const unsigned char*)(KF + (size_t)bh * NKEY * DQK);
    const unsigned char* vg = (const unsigned char*)(VT + (size_t)bh * DV * NKEY);
    int kso[3], kdo[3], vso[2], vdo[2];
#pragma unroll
    for (int i = 0; i < 3; ++i) { const int c = tid + 512 * i; const int key = c / 12, part = c % 12; kso[i] = c * 16; kdo[i] = (key >> 6) * AT_KT + (key & 63) * AT_KROW + part * 16; }
#pragma unroll
    for (int i = 0; i < 2; ++i) { const int c = tid + 512 * i; const int dv = c >> 4, part = c & 15; vso[i] = dv * (NKEY * 2) + part * 16; vdo[i] = AT_VBASE + (part >> 3) * AT_VT + dv * AT_VROW + (part & 7) * 16; }
    v4u sk[3], sv[2];
    LAS unsigned char* const L = F.lds + RING_OFF;
#define AT_LOADK(pair) do { _Pragma("unroll") for (int i = 0; i < 3; ++i) sk[i] = *(const v4u*)(kg + (size_t)(pair) * (128 * 192) + kso[i]); } while (0)
#define AT_LOADV(pair) do { _Pragma("unroll") for (int i = 0; i < 2; ++i) sv[i] = *(const v4u*)(vg + (size_t)(pair) * 256 + vso[i]); } while (0)
#define AT_WRITEK(st) do { _Pragma("unroll") for (int i = 0; i < 3; ++i) *(LAS v4u*)(L + (st) * AT_KST + kdo[i]) = sk[i]; } while (0)
#define AT_WRITEV(st) do { _Pragma("unroll") for (int i = 0; i < 2; ++i) *(LAS v4u*)(L + (st) * AT_VST + vdo[i]) = sv[i]; } while (0)
    const int pr = (r & 0x13) | ((r & 4) << 1) | ((r & 8) >> 1);
    const int koff = kh * AT_KT + pr * AT_KROW + 16 * hh, voff = AT_VBASE + kh * AT_VT + r * AT_VROW + 16 * hh;
    AT_LOADK(0); AT_LOADV(0); AT_WRITEK(0); AT_WRITEV(0); AT_LOADK(1); AT_WRITEK(1);
    __syncthreads();
    f32x16 s0, s1, o0, o1;
#pragma unroll
    for (int i = 0; i < 16; ++i) { s0[i] = negM; s1[i] = negM; o0[i] = 0.f; o1[i] = 0.f; }
#pragma unroll
    for (int ks = 0; ks < 6; ++ks) {
        const bf16x8 k0 = *(const LAS bf16x8*)(L + koff + ks * 32), k1 = *(const LAS bf16x8*)(L + koff + 32 * AT_KROW + ks * 32);
        s0 = mfma32(k0, qf[ks], s0); s1 = mfma32(k1, qf[ks], s1);
    }
    __syncthreads();
    float lrun = 0.f;
    constexpr int NPAIR = NKEY / 128;
    f32x16 n0, n1;
    for (int it2 = 0; it2 < NPAIR; it2 += 2) {
        {
        { const int pk_ = ((it2) + 2 < NPAIR) ? (it2) + 2 : NPAIR - 1, pv_ = ((it2) + 1 < NPAIR) ? (it2) + 1 : NPAIR - 1; AT_LOADK(pk_); AT_LOADV(pv_); }
        const LAS unsigned char* kb = L + (((it2) + 1) & 1) * AT_KST + koff;
        const LAS unsigned char* vb = L + ((it2) & 1) * AT_VST + voff;
        bf16x8 kfa[3], kfb[3], vfa[2], vfb[2];
#pragma unroll
        for (int ks = 0; ks < 3; ++ks) { kfa[ks] = *(const LAS bf16x8*)(kb + ks * 32); kfb[ks] = *(const LAS bf16x8*)(kb + 32 * AT_KROW + ks * 32); }
#pragma unroll
        for (int j = 0; j < 2; ++j) { vfa[j] = *(const LAS bf16x8*)(vb + 32 * j); vfb[j] = *(const LAS bf16x8*)(vb + 32 * AT_VROW + 32 * j); }
        __builtin_amdgcn_sched_barrier(0);
        __builtin_amdgcn_s_setprio(1);
#pragma unroll
        for (int i = 0; i < 16; ++i) { n0[i] = negM; n1[i] = negM; }
#pragma unroll
        for (int ks = 0; ks < 3; ++ks) { n0 = mfma32(kfa[ks], qf[ks], n0); n1 = mfma32(kfb[ks], qf[ks], n1); }
        float ps = 0.f;
#pragma unroll
        for (int i = 0; i < 16; ++i) { s0[i] = AT_EXP(s0[i]); ps += s0[i]; }
        bf16x8 p00, p01, p10, p11;
        { v4u w; w.x = pk2(s0[0], s0[1]); w.y = pk2(s0[2], s0[3]); w.z = pk2(s0[4], s0[5]); w.w = pk2(s0[6], s0[7]); p00 = __builtin_bit_cast(bf16x8, w);
          w.x = pk2(s0[8], s0[9]); w.y = pk2(s0[10], s0[11]); w.z = pk2(s0[12], s0[13]); w.w = pk2(s0[14], s0[15]); p01 = __builtin_bit_cast(bf16x8, w); }
        __builtin_amdgcn_sched_barrier(0);
#pragma unroll
        for (int ks = 0; ks < 3; ++ks) { kfa[ks] = *(const LAS bf16x8*)(kb + (ks + 3) * 32); kfb[ks] = *(const LAS bf16x8*)(kb + 32 * AT_KROW + (ks + 3) * 32); }
        o0 = mfma32(vfa[0], p00, o0); o1 = mfma32(vfb[0], p00, o1);
        o0 = mfma32(vfa[1], p01, o0); o1 = mfma32(vfb[1], p01, o1);
#pragma unroll
        for (int j = 0; j < 2; ++j) { vfa[j] = *(const LAS bf16x8*)(vb + 32 * (j + 2)); vfb[j] = *(const LAS bf16x8*)(vb + 32 * AT_VROW + 32 * (j + 2)); }
#pragma unroll
        for (int i = 0; i < 16; ++i) { s1[i] = AT_EXP(s1[i]); ps += s1[i]; }
        lrun += ps;
        { v4u w; w.x = pk2(s1[0], s1[1]); w.y = pk2(s1[2], s1[3]); w.z = pk2(s1[4], s1[5]); w.w = pk2(s1[6], s1[7]); p10 = __builtin_bit_cast(bf16x8, w);
          w.x = pk2(s1[8], s1[9]); w.y = pk2(s1[10], s1[11]); w.z = pk2(s1[12], s1[13]); w.w = pk2(s1[14], s1[15]); p11 = __builtin_bit_cast(bf16x8, w); }
        __builtin_amdgcn_sched_barrier(0);
#pragma unroll
        for (int ks = 0; ks < 3; ++ks) { n0 = mfma32(kfa[ks], qf[ks + 3], n0); n1 = mfma32(kfb[ks], qf[ks + 3], n1); }
        o0 = mfma32(vfa[0], p10, o0); o1 = mfma32(vfb[0], p10, o1);
        o0 = mfma32(vfa[1], p11, o0); o1 = mfma32(vfb[1], p11, o1);
        __builtin_amdgcn_s_setprio(0);
        __builtin_amdgcn_sched_barrier(0);
        AT_WRITEK((it2) & 1);
        AT_WRITEV(((it2) + 1) & 1);
        __syncthreads();
        }
        {
        { const int pk_ = ((it2 + 1) + 2 < NPAIR) ? (it2 + 1) + 2 : NPAIR - 1, pv_ = ((it2 + 1) + 1 < NPAIR) ? (it2 + 1) + 1 : NPAIR - 1; AT_LOADK(pk_); AT_LOADV(pv_); }
        const LAS unsigned char* kb = L + (((it2 + 1) + 1) & 1) * AT_KST + koff;
        const LAS unsigned char* vb = L + ((it2 + 1) & 1) * AT_VST + voff;
        bf16x8 kfa[3], kfb[3], vfa[2], vfb[2];
#pragma unroll
        for (int ks = 0; ks < 3; ++ks) { kfa[ks] = *(const LAS bf16x8*)(kb + ks * 32); kfb[ks] = *(const LAS bf16x8*)(kb + 32 * AT_KROW + ks * 32); }
#pragma unroll
        for (int j = 0; j < 2; ++j) { vfa[j] = *(const LAS bf16x8*)(vb + 32 * j); vfb[j] = *(const LAS bf16x8*)(vb + 32 * AT_VROW + 32 * j); }
        __builtin_amdgcn_sched_barrier(0);
        __builtin_amdgcn_s_setprio(1);
#pragma unroll
        for (int i = 0; i < 16; ++i) { s0[i] = negM; s1[i] = negM; }
#pragma unroll
        for (int ks = 0; ks < 3; ++ks) { s0 = mfma32(kfa[ks], qf[ks], s0); s1 = mfma32(kfb[ks], qf[ks], s1); }
        float ps = 0.f;
#pragma unroll
        for (int i = 0; i < 16; ++i) { n0[i] = AT_EXP(n0[i]); ps += n0[i]; }
        bf16x8 p00, p01, p10, p11;
        { v4u w; w.x = pk2(n0[0], n0[1]); w.y = pk2(n0[2], n0[3]); w.z = pk2(n0[4], n0[5]); w.w = pk2(n0[6], n0[7]); p00 = __builtin_bit_cast(bf16x8, w);
          w.x = pk2(n0[8], n0[9]); w.y = pk2(n0[10], n0[11]); w.z = pk2(n0[12], n0[13]); w.w = pk2(n0[14], n0[15]); p01 = __builtin_bit_cast(bf16x8, w); }
        __builtin_amdgcn_sched_barrier(0);
#pragma unroll
        for (int ks = 0; ks < 3; ++ks) { kfa[ks] = *(const LAS bf16x8*)(kb + (ks + 3) * 32); kfb[ks] = *(const LAS bf16x8*)(kb + 32 * AT_KROW + (ks + 3) * 32); }
        o0 = mfma32(vfa[0], p00, o0); o1 = mfma32(vfb[0], p00, o1);
        o0 = mfma32(vfa[1], p01, o0); o1 = mfma32(vfb[1], p01, o1);
#pragma unroll
        for (int j = 0; j < 2; ++j) { vfa[j] = *(const LAS bf16x8*)(vb + 32 * (j + 2)); vfb[j] = *(const LAS bf16x8*)(vb + 32 * AT_VROW + 32 * (j + 2)); }
#pragma unroll
        for (int i = 0; i < 16; ++i) { n1[i] = AT_EXP(n1[i]); ps += n1[i]; }
        lrun += ps;
        { v4u w; w.x = pk2(n1[0], n1[1]); w.y = pk2(n1[2], n1[3]); w.z = pk2(n1[4], n1[5]); w.w = pk2(n1[6], n1[7]); p10 = __builtin_bit_cast(bf16x8, w);
          w.x = pk2(n1[8], n1[9]); w.y = pk2(n1[10], n1[11]); w.z = pk2(n1[12], n1[13]); w.w = pk2(n1[14], n1[15]); p11 = __builtin_bit_cast(bf16x8, w); }
        __builtin_amdgcn_sched_barrier(0);
#pragma unroll
        for (int ks = 0; ks < 3; ++ks) { s0 = mfma32(kfa[ks], qf[ks + 3], s0); s1 = mfma32(kfb[ks], qf[ks + 3], s1); }
        o0 = mfma32(vfa[0], p10, o0); o1 = mfma32(vfb[0], p10, o1);
        o0 = mfma32(vfa[1], p11, o0); o1 = mfma32(vfb[1], p11, o1);
        __builtin_amdgcn_s_setprio(0);
        __builtin_amdgcn_sched_barrier(0);
        AT_WRITEK((it2 + 1) & 1);
        AT_WRITEV(((it2 + 1) + 1) & 1);
        __syncthreads();
        }
    }
#undef AT_LOADK
#undef AT_LOADV
#undef AT_WRITEK
#undef AT_WRITEV
    lrun += __shfl_xor(lrun, 32);
    LAS float* mg = (LAS float*)(F.lds + RING_OFF) + (qg * 64 + lane);
    if (kh == 1) {
        mg[256] = lrun;
#pragma unroll
        for (int i = 0; i < 16; ++i) { mg[(2 + i) * 256] = o0[i]; mg[(18 + i) * 256] = o1[i]; }
    }
    __syncthreads();
    if (kh == 0) {
        const float inv = 1.0f / (lrun + mg[256]);
        bf16* op = ATT + (size_t)tok * 512 + h * DV + 4 * hh;
#pragma unroll
        for (int g = 0; g < 4; ++g) {
            float x0[4], x1[4];
#pragma unroll
            for (int e = 0; e < 4; ++e) { x0[e] = (o0[4 * g + e] + mg[(2 + 4 * g + e) * 256]) * inv; x1[e] = (o1[4 * g + e] + mg[(18 + 4 * g + e) * 256]) * inv; }
            v2u w; w.x = pk2(x0[0], x0[1]); w.y = pk2(x0[2], x0[3]); *(v2u*)(op + 8 * g) = w;
            w.x = pk2(x1[0], x1[1]); w.y = pk2(x1[2], x1[3]); *(v2u*)(op + 32 + 8 * g) = w;
        }
    }
}
__device__ __forceinline__ void attn_phase(Frame& F) {
    const unsigned x0 = xb_xcc_id() & 7u;
    float negM;
    {
        const float* qg_ = F.ap->in[15]; const float* kg_ = F.ap->in[16];
        float mq = fmaxf(fabsf(qg_[F.lane]), (F.lane < 32) ? fabsf(qg_[64 + F.lane]) : 0.f), mk = fmaxf(fabsf(kg_[F.lane]), (F.lane < 32) ? fabsf(kg_[64 + F.lane]) : 0.f);
#pragma unroll
        for (int o = 1; o < 64; o <<= 1) { mq = fmaxf(mq, __shfl_xor(mq, o)); mk = fmaxf(mk, __shfl_xor(mk, o)); }
        negM = -14.2f * mq * mk; }
    for (;;) {
        __syncthreads();
        if (F.tid == 0) { int unit = -1;
            for (unsigned d = 0; d < 8; ++d) { const unsigned x = (x0 + d) & 7u; gu32* hq = F.ctl + CW_ATTQ + 64 * x;
                if (d != 0u && __hip_atomic_load(hq, RLX_AGENT) >= 128u) continue;
                const unsigned j = __hip_atomic_fetch_add(hq, 1u, RLX_AGENT);
                if (j < 128u) { unit = (int)(x * 128u + j); break; } }
            F.MISC[16] = (unsigned)unit; }
        __syncthreads();
        const int unit = (int)F.MISC[16];
        if (unit < 0) break;
        const int x = unit >> 7, j = unit & 127;
        attn_unit(F, x + 8 * (j >> 5), j & 31, negM);
    }
}

#define AS4 __attribute__((address_space(4)))
#define PHASE_FRAME() Frame F; { int t_ = threadIdx.x; asm volatile("" : "+v"(t_)); F.tid = t_; F.lane = t_ & 63; F.wave = __builtin_amdgcn_readfirstlane(t_ >> 6); \
    int bx_ = blockIdx.x, g_ = gridDim.x; asm volatile("" : "+s"(bx_), "+s"(g_)); F.G = g_; F.bx = bx_; F.vcu = (g_ % 8 == 0) ? (bx_ % 8) * (g_ / 8) + bx_ / 8 : bx_; \
    const AS4 Args* ap_ = (const AS4 Args*)__builtin_amdgcn_kernarg_segment_ptr(); asm volatile("" : "+s"(ap_)); F.ap = ap_; F.ws = ap_->ws; F.ctl = (gu32*)(F.ws + WS_CTL); \
    F.lds = (LAS unsigned char*)lds; F.MISC = (volatile LAS unsigned*)(F.lds + MISC_OFF); } \
    unsigned char* const ws = F.ws; const float* const MOD = (const float*)(ws + WS_MOD); bf16* const HX = (bf16*)(ws + WS_HX); (void)MOD; (void)HX
#define ARG(i) (F.ap->in[i])
__global__ void __launch_bounds__(512, 2) mk_fwd(Args args_unused) {
    extern __shared__ __attribute__((aligned(16))) unsigned char lds[];
    int lo, hi;
    XcdBarrier bar;
    {
        PHASE_FRAME();
        for (int u = F.tid; u < 512 / 4; u += 512) ((LAS unsigned*)(F.lds + LDSCTL_OFF))[u] = 0u;
        __syncthreads();
        bar.bar = (unsigned*)(F.ctl + CW_BAR); bar.x = 0; bar.st = nullptr;
        if (N_LAUNCHES == 1) bar = xcd_barrier_post((unsigned*)(F.ctl + CW_BAR), F.MISC + 8);
        lo = F.ap->ph_lo; hi = F.ap->ph_hi;
    }
#define IN(k) (lo <= (k) && (k) < hi)
#ifdef DBG_TIME_PHASE
#ifndef DBG_TIME_END
#define DBG_TIME_END (DBG_TIME_PHASE + 1)
#endif
#ifndef DBG_TIME_Q
#define DBG_TIME_Q 8.0f
#endif
#define STAMP(k) do { if (blockIdx.x == 0 && threadIdx.x == 0) { const AS4 Args* q_ = (const AS4 Args*)__builtin_amdgcn_kernarg_segment_ptr(); ((unsigned long long*)(q_->ws + 65536))[(k)] = __builtin_amdgcn_s_memrealtime(); } } while (0)
#else
#define STAMP(k) do { } while (0)
#endif
#define SEAM(k) do { if (IN(k) && IN((k) + 1)) xcd_barrier(bar); STAMP((k) + 1); } while (0)
    STAMP(0);

    if (IN(0)) { PHASE_FRAME(); p0_prep(F); } if (IN(0) && IN(2)) xcd_barrier(bar); STAMP(1); STAMP(2);
    if (IN(2)) { PHASE_FRAME();
        if (F.bx < 16) {
            const int ct = F.bx >> 2, rq = F.bx & 3, r0 = ct * 256 + rq * 64 + F.wave * 8;
            { f32x4 mA[4], mB[4]; norm_vecs(ARG(6), MOD + 4 * 6144, MOD + 4 * 6144 + 1024, F.lane, mA, mB);
              f32x4 v[8][4];
#pragma unroll
              for (int u = 0; u < 8; ++u) norm_row_load(ARG(2) + (size_t)(r0 + u) * 1024, F.lane, v[u]);
#pragma unroll
              for (int u = 0; u < 8; ++u) norm_row_finish_v(v[u], mA, mB, HX + (size_t)(MT + r0 + u) * 1024, F.lane); }
            VM_WAIT(); __syncthreads();
            pg8::Gemm g{HX, (const bf16*)(ws + WS_WIN), MA, DINP, 1024}; OneUnit S{64 + ct, 3};
            EpiInProj E{(bf16*)(ws + WS_FT), (bf16*)(ws + WS_QL), (bf16*)(ws + WS_KVK), (bf16*)(ws + WS_GATES), ARG(9), 0, rq};
            pg8::gemm_phase<EpiInProj, OneUnit, true, true>(F.lds + RING_OFF, g, S, E);
        } else {
            const int gw = ((int)F.bx - 16) * 8 + F.wave, NGW = (F.G - 16) * 8;
            if ((NGW & 3) == 0) {
                const int bb = gw & 3, idx = gw >> 2, nper = NGW >> 2;
                f32x4 mA[4], mB[4]; norm_vecs(ARG(6), MOD + bb * 6144, MOD + bb * 6144 + 1024, F.lane, mA, mB);
                for (int r = idx; r < SEQ; r += 4 * nper) { f32x4 v[4][4];
#pragma unroll
                    for (int u = 0; u < 4; ++u) { const int rr = r + u * nper; if (rr < SEQ) norm_row_load(ARG(0) + (size_t)(bb * SEQ + rr) * 1024, F.lane, v[u]); }
#pragma unroll
                    for (int u = 0; u < 4; ++u) { const int rr = r + u * nper; if (rr < SEQ) norm_row_finish_v(v[u], mA, mB, HX + (size_t)(bb * SEQ + rr) * 1024, F.lane); } }
            } else
            for (int row = gw; row < MT; row += NGW) { const int b = row >> 12; norm_mod_row(ARG(0) + (size_t)row * 1024, ARG(6), MOD + b * 6144, MOD + b * 6144 + 1024, HX + (size_t)row * 1024, F.lane); }
            prep_late(F, gw, NGW);
        }
    } SEAM(2);
    if (IN(3)) { PHASE_FRAME();
        pg8::Gemm g{HX, (const bf16*)(ws + WS_WIN), MT, DINP, 1024}; pg8::StaticOrder S; S.init(MT, DINP, F.G, (int)F.bx);
        EpiInProj E{(bf16*)(ws + WS_FT), (bf16*)(ws + WS_QL), (bf16*)(ws + WS_KVK), (bf16*)(ws + WS_GATES), ARG(9), 0, -1};
        pg8::gemm_phase<EpiInProj, pg8::StaticOrder, true, true>(F.lds + RING_OFF, g, S, E);
    } SEAM(3);
    if (IN(4)) { { PHASE_FRAME();
        { pg8::Gemm g{(const bf16*)(ws + WS_KVK), (const bf16*)(ws + WS_WKVB), MA, 1024, 256}; pg8::StaticOrder S; S.init(MA, 1024, F.G, (int)F.bx);
          EpiKvUp E{(const bf16*)(ws + WS_KVK), (bf16*)(ws + WS_KF), (bf16*)(ws + WS_VT)};
          pg8::gemm_phase<EpiKvUp, pg8::StaticOrder, true, true>(F.lds + RING_OFF, g, S, E); }
        { pg8::Gemm g{(const bf16*)(ws + WS_QL), (const bf16*)(ws + WS_WQB), MT, 768, 256}; pg8::StaticOrder S; S.init(MT, 768, F.G, (int)(((unsigned)F.bx + 192u) % (unsigned)F.G));
          EpiStore<0> E{(bf16*)(ws + WS_QR), 768};
          pg8::gemm_phase<EpiStore<0>, pg8::StaticOrder, true, true>(F.lds + RING_OFF, g, S, E); }
        }
        { PHASE_FRAME();
          const int gw = F.vcu * 8 + F.wave, NGW = F.G * 8; LAS bf16* fscr = (LAS bf16*)(F.lds + RING_OFF + F.wave * 8192);
          for (int it = gw; it < NB * 512; it += NGW) fold_item((const bf16*)(ws + WS_FT), (bf16*)(ws + WS_FE), (bf16*)(ws + WS_FO), HX, fscr, it, F.lane); }
    } SEAM(4);
    if (IN(5)) { PHASE_FRAME();
        const int gw = F.vcu * 8 + F.wave, NGW = F.G * 8;
        finalize_all(F);
    } SEAM(5);
    if (IN(6)) { PHASE_FRAME();
        if (F.bx < 128) { const int uid = F.bx; const int b = uid >> 5; const int pm = (uid >> 1) & 15;
            pg8::Gemm g{(const bf16*)(ws + WS_DFT), (const bf16*)(ws + ((pm >> 3) ? WS_FO : WS_FE)) + (size_t)b * 512 * 2048, 4096, 512, 2048}; OneUnit S{pm, uid & 1};
            EpiDft E{HX, (const bf16*)(ws + WS_FT), b};
            pg8::gemm_phase<EpiDft, OneUnit, true, true>(F.lds + RING_OFF, g, S, E); }
        attn_phase(F);
    } SEAM(6);
    if (IN(7)) { PHASE_FRAME();
        { pg8::Gemm g{HX, (const bf16*)(ws + WS_WF), MT, 1024, 1024}; pg8::StaticOrder S; S.init(MT, 1024, F.G, (int)F.bx);
          EpiMerge1 E{(const bf16*)(ws + WS_GATES), (bf16*)(ws + WS_Y)};
          pg8::gemm_phase<EpiMerge1, pg8::StaticOrder, true, true>(F.lds + RING_OFF, g, S, E); }
        { pg8::Gemm g{(const bf16*)(ws + WS_ATT), (const bf16*)(ws + WS_WMO), MT, 1024, 512}; pg8::StaticOrder S; S.init(MT, 1024, F.G, (int)F.bx);
          EpiMerge2 E{(const bf16*)(ws + WS_GATES), (bf16*)(ws + WS_Y)};
          pg8::gemm_phase<EpiMerge2, pg8::StaticOrder, true, true>(F.lds + RING_OFF, g, S, E); }
    } SEAM(7);
    if (IN(8)) { PHASE_FRAME();
        pg8::Gemm g{(const bf16*)(ws + WS_Y), (const bf16*)(ws + WS_WOUT), MT, 1024, 1024}; pg8::StaticOrder S; S.init(MT, 1024, F.G, (int)F.bx);
        EpiResidX E{ARG(0), F.ap->out, MOD, ARG(7), HX, (float*)(ws + WS_RS2)};
        pg8::gemm_phase<EpiResidX, pg8::StaticOrder, true, true>(F.lds + RING_OFF, g, S, E);
    } SEAM(8);
    STAMP(10);
    if (IN(10)) { { PHASE_FRAME(); wdown_copy(F); }
        __syncthreads();
        PHASE_FRAME();
        pg8::Gemm g{HX, (const bf16*)(ws + WS_WUP), MT, DFF, 1024}; pg8::StaticOrder S; S.init(MT, DFF, F.G, (int)F.bx);
        EpiUp E{(bf16*)(ws + WS_U), (const float*)(ws + WS_RS2), (const float*)(ws + WS_BIAS2)};
        pg8::gemm_phase<EpiUp, pg8::StaticOrder, true, true>(F.lds + RING_OFF, g, S, E);
    } SEAM(10);
    if (IN(11)) { PHASE_FRAME();
        pg8::Gemm g{(const bf16*)(ws + WS_U), (const bf16*)(ws + WS_WDOWN), MT, 1024, DFF}; pg8::StaticOrder S; S.init(MT, 1024, F.G, (int)F.bx);
        EpiResid E{F.ap->out, F.ap->out, MOD + 5120};
        pg8::gemm_phase<EpiResid, pg8::StaticOrder, true, true>(F.lds + RING_OFF, g, S, E);
    }
#ifdef DBG_TIME_PHASE
    {
        STAMP(12);
        if (blockIdx.x == 0 && threadIdx.x == 0) { asm volatile("s_waitcnt vmcnt(0)" ::: "memory"); }
        xcd_barrier(bar);
        PHASE_FRAME();
        const unsigned long long* ts = (const unsigned long long*)(ws + 65536);
        const unsigned long long a0 = __hip_atomic_load(ts + DBG_TIME_PHASE, RLX_AGENT), a1 = __hip_atomic_load(ts + DBG_TIME_END, RLX_AGENT);
        const float val = floorf((float)(a1 - a0) * (0.01f / DBG_TIME_Q) + 0.5f) * (1000.0f * DBG_TIME_Q);
        float* o = F.ap->out;
        for (size_t i = (size_t)F.vcu * 512 + F.tid; i < (size_t)MT * 1024; i += (size_t)F.G * 512) o[i] = val;
    }
#endif
#ifdef DBG_DUMP_OFF
    {
        xcd_barrier(bar);
        PHASE_FRAME();
        const bf16* src = (const bf16*)(ws + (size_t)DBG_DUMP_OFF); float* o = F.ap->out;
        for (size_t i = (size_t)F.vcu * 512 + F.tid; i < (size_t)MT * 1024; i += (size_t)F.G * 512) o[i] = bf2f(src[i]);
    }
#endif
#undef IN
#undef SEAM
}

#ifndef DBG_LO
#define DBG_LO 0
#endif
#ifndef DBG_HI
#define DBG_HI N_PHASES
#endif
extern "C" void kernel_launch(void* const* d_in, const int* in_sizes, int n_in, void* d_out, int out_size, void* d_ws, size_t ws_size, hipStream_t stream) {
    static int grid = 0;
    if (grid == 0) {
        if (n_in != 21 || in_sizes[0] != MT * DM || out_size != MT * DM || ws_size < WS_END) { fprintf(stderr, "kernel_launch: unexpected shapes (n_in %d, in0 %d, out %d, ws %zu)\n", n_in, n_in > 0 ? in_sizes[0] : -1, out_size, ws_size); grid = -1; return; }
        int dev = 0, cus = 0, per_cu = 0;
        if (hipGetDevice(&dev) != hipSuccess || hipDeviceGetAttribute(&cus, hipDeviceAttributeMultiprocessorCount, dev) != hipSuccess) { grid = -1; return; }
        if (hipFuncSetAttribute((const void*)mk_fwd, hipFuncAttributeMaxDynamicSharedMemorySize, LDS_BYTES) != hipSuccess) { fprintf(stderr, "kernel_launch: hipFuncSetAttribute failed\n"); grid = -1; return; }
        if (hipOccupancyMaxActiveBlocksPerMultiprocessor(&per_cu, (const void*)mk_fwd, 512, LDS_BYTES) != hipSuccess || per_cu < 1) fprintf(stderr, "kernel_launch: occupancy query reports %d per CU\n", per_cu);
        (void)hipGetLastError();
        grid = cus;
        if (grid < 128) { fprintf(stderr, "kernel_launch: needs >= 128 CUs\n"); grid = -1; return; }
    }
    if (grid < 0) return;
    if (hipMemsetAsync((char*)d_ws + WS_CTL, 0, 256 * 1024, stream) != hipSuccess) return;
    Args a{};
    for (int i = 0; i < 21; ++i) a.in[i] = (const float*)d_in[i];
    a.out = (float*)d_out; a.ws = (unsigned char*)d_ws;
    for (int li = 0; li < N_LAUNCHES; ++li) {
        a.ph_lo = (N_LAUNCHES == 1) ? DBG_LO : li; a.ph_hi = (N_LAUNCHES == 1) ? DBG_HI : li + 1; a.li = li;
        hipLaunchKernelGGL(mk_fwd, dim3(grid), dim3(512), LDS_BYTES, stream, a);
        const hipError_t le = hipPeekAtLastError();
        if (le != hipSuccess) { fprintf(stderr, "kernel_launch: launch %d failed: %s\n", li, hipGetErrorName(le)); break; }
    }
}
```
